# Optimizing an MI355X kernel written in HIP

```python
import math
import jax, jax.numpy as jnp
from jax import lax
import numpy as np

D_MODEL = 2048
BATCH = 4
SEQ = 2048
DEPTH = 1

N_MEM = 256
Q_BLOCK = 128
LN_EPS = 1e-5
DIFF_HEADS = 8
DIFF_HEAD_DIM = 128
DIFF_V_DIM = 2 * DIFF_HEAD_DIM
DSA_HEADS = 8
DSA_HEAD_DIM = 128
DSA_KV_RANK = 512
IDX_HEADS = 16
IDX_HEAD_DIM = 64
DSA_TOPK_MAX = 256
REL_BUCKETS = 32
REL_MAX_DIST = 128
XATTN_HEADS = 4
XATTN_HEAD_DIM = 128
N_EXPERTS = 64
EXPERT_DIM = 512
TOP_K = 8
N_GROUPS = 8
TOPK_GROUPS = 4
ROUTED_SCALE = 2.5
SHARED_DIM = 512
MOE_BLOCK = 128
DN_ALPHA = (2 * DEPTH) ** 0.25
DN_BETA = (8 * DEPTH) ** -0.25
IN_SIZES = (DIFF_HEADS * 2 * DIFF_HEAD_DIM, DIFF_HEADS * 2 * DIFF_HEAD_DIM, DIFF_HEADS * DIFF_V_DIM,
            DSA_HEADS * DSA_HEAD_DIM, DSA_KV_RANK, IDX_HEADS * IDX_HEAD_DIM, IDX_HEAD_DIM, IDX_HEADS,
            D_MODEL, D_MODEL)
IN_COLS = sum(IN_SIZES)

kernel_name = 'hybrid_diffattn_dsa_moe_deepnorm'


def layer_norm(x, g, b):
    xf = x.astype(jnp.float32)
    mu = jnp.mean(xf, axis=-1, keepdims=True)
    var = jnp.mean(jnp.square(xf - mu), axis=-1, keepdims=True)
    return ((xf - mu) * lax.rsqrt(var + LN_EPS)).astype(x.dtype) * g + b


def rms_norm(x, g):
    xf = x.astype(jnp.float32)
    return (xf * lax.rsqrt(jnp.mean(xf * xf, axis=-1, keepdims=True) + LN_EPS)).astype(x.dtype) * g


def split_cols(a, sizes):
    outs, start = [], 0
    for s in sizes:
        outs.append(a[..., start:start + s])
        start += s
    return outs


def to_blocks(a):
    b, t = a.shape[:2]
    return jnp.moveaxis(a.reshape(b, t // Q_BLOCK, Q_BLOCK, *a.shape[2:]), 1, 0)


def from_blocks(a):
    nb, b, qb = a.shape[:3]
    return jnp.moveaxis(a, 0, 1).reshape(b, nb * qb, *a.shape[3:])


def rel_bucket(rel):
    n = jnp.maximum(rel, 0)
    max_exact = REL_BUCKETS // 2
    nf = jnp.maximum(n, 1).astype(jnp.float32)
    large = max_exact + (jnp.log(nf / max_exact) / math.log(REL_MAX_DIST / max_exact)
                         * (REL_BUCKETS - max_exact)).astype(jnp.int32)
    large = jnp.minimum(large, REL_BUCKETS - 1)
    return jnp.where(n < max_exact, n, large)


def differential_attention(q, k, v, positions, table, lam):
    scale = DIFF_HEAD_DIM ** -0.5

    def block(args):
        qb, pq = args
        rel = pq[:, :, None] - positions[:, None, :]
        bias = jnp.moveaxis(table[rel_bucket(rel)], -1, 1)
        s = jnp.einsum('bqhcd,bkhcd->bchqk', qb, k) * scale + bias[:, None]
        s = jnp.where((rel >= 0)[:, None, None], s.astype(jnp.float32), -jnp.inf)
        p = jax.nn.softmax(s, axis=-1)
        p = (p[:, 0] - lam * p[:, 1]).astype(v.dtype)
        return jnp.einsum('bhqk,bkhe->bqhe', p, v)

    return from_blocks(lax.map(block, (to_blocks(q), to_blocks(positions))))


def dsa_attention(q, c, q_idx, k_idx, w_idx, positions, table, w_uk, w_uv, k_sel):
    scale = DSA_HEAD_DIM ** -0.5
    w_idx = w_idx * (IDX_HEADS ** -0.5 * IDX_HEAD_DIM ** -0.5)

    def block(args):
        qb, qib, wb, pq = args
        rel = pq[:, :, None] - positions[:, None, :]
        idx_logits = jax.nn.relu(jnp.einsum('bqhd,bkd->bqhk', qib, k_idx))
        score = jnp.einsum('bqhk,bqh->bqk', idx_logits, wb).astype(jnp.float32)
        score = jnp.where(rel >= 0, score, -jnp.inf)
        _, sel = lax.top_k(score, k_sel)
        c_sel = jax.vmap(lambda cb, ib: cb[ib])(c, sel)
        rel_sel = jnp.take_along_axis(rel, sel, axis=-1)
        bias = jnp.moveaxis(table[rel_bucket(rel_sel)], -1, 2)
        q_lat = jnp.einsum('bqhd,hdr->bqhr', qb, w_uk)
        s = jnp.einsum('bqhr,bqkr->bqhk', q_lat, c_sel) * scale + bias
        s = jnp.where((rel_sel >= 0)[:, :, None, :], s.astype(jnp.float32), -jnp.inf)
        p = jax.nn.softmax(s, axis=-1).astype(c.dtype)
        o_lat = jnp.einsum('bqhk,bqkr->bqhr', p, c_sel)
        return jnp.einsum('bqhr,hrd->bqhd', o_lat, w_uv)

    xs = (to_blocks(q), to_blocks(q_idx), to_blocks(w_idx), to_blocks(positions))
    return from_blocks(lax.map(block, xs))


def hybrid_mixer(h, positions, rel_table, w_in, diff_lambda, diff_subln, idx_k_g, idx_k_b,
                 kv_norm_g, w_uk, w_uv, w_proj_diff, w_proj_dsa, w_mix_out, lambda_init):
    b, t, _ = h.shape
    proj = h @ w_in
    q_d, k_d, v_d, q_s, c_kv, q_i, k_i, w_i, g_d, g_s = split_cols(proj, IN_SIZES)

    q_d = q_d.reshape(b, t, DIFF_HEADS, 2, DIFF_HEAD_DIM)
    k_d = k_d.reshape(b, t, DIFF_HEADS, 2, DIFF_HEAD_DIM)
    v_d = v_d.reshape(b, t, DIFF_HEADS, DIFF_V_DIM)
    lq1, lk1, lq2, lk2 = [diff_lambda[i].astype(jnp.float32) for i in range(4)]
    lam = jnp.exp(jnp.sum(lq1 * lk1)) - jnp.exp(jnp.sum(lq2 * lk2)) + lambda_init
    o_d = differential_attention(q_d, k_d, v_d, positions, rel_table[:, :DIFF_HEADS], lam)
    o_d = (rms_norm(o_d, diff_subln) * (1.0 - lambda_init)).reshape(b, t, DIFF_HEADS * DIFF_V_DIM)

    k_sel = min(DSA_TOPK_MAX, t // 4)
    q_s = q_s.reshape(b, t, DSA_HEADS, DSA_HEAD_DIM)
    c = rms_norm(c_kv, kv_norm_g)
    q_i = q_i.reshape(b, t, IDX_HEADS, IDX_HEAD_DIM)
    k_i = layer_norm(k_i, idx_k_g, idx_k_b)
    o_s = dsa_attention(q_s, c, q_i, k_i, w_i, positions, rel_table[:, DIFF_HEADS:], w_uk, w_uv, k_sel)
    o_s = o_s.reshape(b, t, DSA_HEADS * DSA_HEAD_DIM)

    merged = jax.nn.sigmoid(g_d) * (o_d @ w_proj_diff) + jax.nn.sigmoid(g_s) * (o_s @ w_proj_dsa)
    return merged @ w_mix_out


def memory_cross_attention(h, mem, wq, wkv, wo):
    b, t, _ = h.shape
    q = (h @ wq).reshape(b, t, XATTN_HEADS, XATTN_HEAD_DIM)
    kv = (mem @ wkv).reshape(b, mem.shape[1], 2, XATTN_HEADS, XATTN_HEAD_DIM)
    k, v = kv[:, :, 0], kv[:, :, 1]
    s = jnp.einsum('bqhd,bkhd->bhqk', q, k) * (XATTN_HEAD_DIM ** -0.5)
    p = jax.nn.softmax(s.astype(jnp.float32), axis=-1).astype(v.dtype)
    o = jnp.einsum('bhqk,bkhd->bqhd', p, v).reshape(b, t, XATTN_HEADS * XATTN_HEAD_DIM)
    return o @ wo


def moe_ffn(h, router_w, router_bias, w1, w3, w2, sw1, sw3, sw2):
    b, t, d = h.shape
    n = b * t
    hf = h.reshape(n, d)
    scores = jax.nn.sigmoid((hf @ router_w).astype(jnp.float32))
    sel = scores + router_bias.astype(jnp.float32)
    grp = sel.reshape(n, N_GROUPS, N_EXPERTS // N_GROUPS)
    grp_score = jnp.sum(lax.top_k(grp, 2)[0], axis=-1)
    _, top_g = lax.top_k(grp_score, TOPK_GROUPS)
    g_mask = jnp.sum(jax.nn.one_hot(top_g, N_GROUPS, dtype=jnp.float32), axis=1) > 0
    e_mask = jnp.repeat(g_mask, N_EXPERTS // N_GROUPS, axis=1)
    _, idx = lax.top_k(jnp.where(e_mask, sel, -jnp.inf), TOP_K)
    gate = jnp.take_along_axis(scores, idx, axis=-1)
    gate = gate / jnp.sum(gate, axis=-1, keepdims=True) * ROUTED_SCALE

    flat_e = idx.reshape(-1)
    flat_tok = jnp.repeat(jnp.arange(n, dtype=jnp.int32), TOP_K)
    flat_g = gate.reshape(-1).astype(h.dtype)
    order = jnp.argsort(flat_e)
    se, stok, sg = flat_e[order], flat_tok[order], flat_g[order]
    counts = jnp.zeros((N_EXPERTS,), jnp.int32).at[flat_e].add(1)
    padded = (counts + MOE_BLOCK - 1) // MOE_BLOCK * MOE_BLOCK
    pad_end = jnp.cumsum(padded)
    pad_start = pad_end - padded
    start = jnp.cumsum(counts) - counts
    dest = pad_start[se] + (jnp.arange(n * TOP_K, dtype=jnp.int32) - start[se])
    n_blocks = (n * TOP_K + N_EXPERTS * (MOE_BLOCK - 1) + MOE_BLOCK - 1) // MOE_BLOCK
    rows = n_blocks * MOE_BLOCK
    row_tok = jnp.full((rows,), n, jnp.int32).at[dest].set(stok)
    row_g = jnp.zeros((rows,), h.dtype).at[dest].set(sg)
    block_e = jnp.clip(jnp.searchsorted(pad_end, jnp.arange(n_blocks, dtype=jnp.int32) * MOE_BLOCK,
                                        side='right'), 0, N_EXPERTS - 1)
    h_pad = jnp.concatenate([hf, jnp.zeros((1, d), h.dtype)], axis=0)

    def expert_block(args):
        tok, e = args
        xb = h_pad[tok]
        return (jax.nn.silu(xb @ w1[e]) * (xb @ w3[e])) @ w2[e]

    y_rows = lax.map(expert_block, (row_tok.reshape(n_blocks, MOE_BLOCK), block_e))
    y_rows = y_rows.reshape(rows, d) * row_g[:, None]
    routed = jax.ops.segment_sum(y_rows, row_tok, num_segments=n + 1)[:n]
    shared = (jax.nn.silu(hf @ sw1) * (hf @ sw3)) @ sw2
    return (routed + shared).reshape(b, t, d)


def setup_inputs(seed: int = 0) -> dict:
    key = jax.random.key(seed)
    ks = iter(jax.random.split(key, 40))
    f32 = jnp.float32

    def nrm(shape, scale):
        return jax.random.normal(next(ks), shape, f32) * scale

    def gain(shape):
        return 1.0 + nrm(shape, 0.02)

    L, D = DEPTH, D_MODEL
    x = nrm((BATCH, SEQ, D), 1.0)
    mem = nrm((BATCH, N_MEM, D), 1.0)
    start = jax.random.randint(next(ks), (BATCH, 1), 0, 1024, dtype=jnp.int32)
    positions = start + jnp.arange(SEQ, dtype=jnp.int32)[None, :]
    return {
        'x': x,
        'mem': mem,
        'positions': positions,
        'rel_bias_table': nrm((REL_BUCKETS, DIFF_HEADS + DSA_HEADS), 0.2),
        'w_in': nrm((L, D, IN_COLS), D ** -0.5),
        'diff_lambda': nrm((L, 4, DIFF_HEAD_DIM), 0.1),
        'diff_subln': gain((L, DIFF_V_DIM)),
        'idx_k_g': gain((L, IDX_HEAD_DIM)),
        'idx_k_b': nrm((L, IDX_HEAD_DIM), 0.02),
        'kv_norm_g': gain((L, DSA_KV_RANK)),
        'w_uk': nrm((L, DSA_HEADS, DSA_HEAD_DIM, DSA_KV_RANK), DSA_HEAD_DIM ** -0.5),
        'w_uv': nrm((L, DSA_HEADS, DSA_KV_RANK, DSA_HEAD_DIM), DSA_KV_RANK ** -0.5),
        'w_proj_diff': nrm((L, DIFF_HEADS * DIFF_V_DIM, D), (DIFF_HEADS * DIFF_V_DIM) ** -0.5 * DN_BETA),
        'w_proj_dsa': nrm((L, DSA_HEADS * DSA_HEAD_DIM, D), (DSA_HEADS * DSA_HEAD_DIM) ** -0.5 * DN_BETA),
        'w_mix_out': nrm((L, D, D), D ** -0.5 * DN_BETA),
        'ln1_g': gain((L, D)),
        'ln1_b': nrm((L, D), 0.02),
        'xattn_wq': nrm((L, D, XATTN_HEADS * XATTN_HEAD_DIM), D ** -0.5),
        'xattn_wkv': nrm((L, D, 2 * XATTN_HEADS * XATTN_HEAD_DIM), D ** -0.5),
        'xattn_wo': nrm((L, XATTN_HEADS * XATTN_HEAD_DIM, D), (XATTN_HEADS * XATTN_HEAD_DIM) ** -0.5 * DN_BETA),
        'ln2_g': gain((L, D)),
        'ln2_b': nrm((L, D), 0.02),
        'router_w': nrm((L, D, N_EXPERTS), D ** -0.5),
        'router_bias': nrm((L, N_EXPERTS), 0.01),
        'exp_w1': nrm((L, N_EXPERTS, D, EXPERT_DIM), D ** -0.5),
        'exp_w3': nrm((L, N_EXPERTS, D, EXPERT_DIM), D ** -0.5),
        'exp_w2': nrm((L, N_EXPERTS, EXPERT_DIM, D), EXPERT_DIM ** -0.5 * DN_BETA),
        'sh_w1': nrm((L, D, SHARED_DIM), D ** -0.5),
        'sh_w3': nrm((L, D, SHARED_DIM), D ** -0.5),
        'sh_w2': nrm((L, SHARED_DIM, D), SHARED_DIM ** -0.5 * DN_BETA),
        'ln3_g': gain((L, D)),
        'ln3_b': nrm((L, D), 0.02),
    }


def reference(x, mem, positions, rel_bias_table, w_in, diff_lambda, diff_subln, idx_k_g, idx_k_b,
              kv_norm_g, w_uk, w_uv, w_proj_diff, w_proj_dsa, w_mix_out, ln1_g, ln1_b,
              xattn_wq, xattn_wkv, xattn_wo, ln2_g, ln2_b, router_w, router_bias,
              exp_w1, exp_w3, exp_w2, sh_w1, sh_w3, sh_w2, ln3_g, ln3_b):
    h = x
    for l in range(DEPTH):
        lambda_init = 0.8 - 0.6 * math.exp(-0.3 * l)
        y = hybrid_mixer(h, positions, rel_bias_table, w_in[l], diff_lambda[l], diff_subln[l],
                         idx_k_g[l], idx_k_b[l], kv_norm_g[l], w_uk[l], w_uv[l],
                         w_proj_diff[l], w_proj_dsa[l], w_mix_out[l], lambda_init)
        h = layer_norm(DN_ALPHA * h + y, ln1_g[l], ln1_b[l])
        y = memory_cross_attention(h, mem, xattn_wq[l], xattn_wkv[l], xattn_wo[l])
        h = layer_norm(DN_ALPHA * h + y, ln2_g[l], ln2_b[l])
        y = moe_ffn(h, router_w[l], router_bias[l], exp_w1[l], exp_w3[l], exp_w2[l],
                    sh_w1[l], sh_w3[l], sh_w2[l])
        h = layer_norm(DN_ALPHA * h + y, ln3_g[l], ln3_b[l])
    return h
```

```cpp
#include <hip/hip_runtime.h>
#include <cstdio>
#include <cstdint>

#define LAS __attribute__((address_space(3)))
#define GAS __attribute__((address_space(1)))
typedef unsigned short bf16_t;
typedef short bf16x8 __attribute__((ext_vector_type(8)));
typedef short s16x4 __attribute__((ext_vector_type(4)));
typedef float f32x4 __attribute__((ext_vector_type(4)));
typedef float f32x2 __attribute__((ext_vector_type(2)));
typedef float f32x16 __attribute__((ext_vector_type(16)));
typedef unsigned u32x4 __attribute__((ext_vector_type(4)));
typedef unsigned u32x2 __attribute__((ext_vector_type(2)));

__device__ __forceinline__ unsigned cvt_pk_bf16(float lo, float hi) { unsigned r; asm volatile("v_cvt_pk_bf16_f32 %0, %1, %2" : "=v"(r) : "v"(lo), "v"(hi)); return r; }
__device__ __forceinline__ float bf_lo(unsigned w) { return __builtin_bit_cast(float, w << 16); }
__device__ __forceinline__ float bf_hi(unsigned w) { return __builtin_bit_cast(float, w & 0xffff0000u); }
__device__ __forceinline__ float sigmoidf_(float v) { return 1.0f / (1.0f + __expf(-v)); }
__device__ __forceinline__ float wave_sum(float v) {
#pragma unroll
    for (int o = 1; o < 64; o <<= 1) v += __shfl_xor(v, o);
    return v;
}

namespace pg8 {
constexpr int BM = 256, BK = 64, HALF = 128, HTB = HALF * BK * 2, STAGE_BYTES = 8 * HTB;
__host__ __device__ __forceinline__ int lds_byte(int r, int c) { const int st = (r >> 4) * 2 + (c >> 5), rr = r & 15, cc = c & 31, ob = rr * 64 + cc * 2; return st * 1024 + (ob ^ (((ob >> 9) & 1) << 5)); }
__host__ __device__ __forceinline__ void stage_rc(int b, int& R, int& C) { const int st = b / 1024, sb = b % 1024, swz = sb ^ (((sb >> 9) & 1) << 5); R = (st >> 1) * 16 + swz / 64; C = (st & 1) * 32 + (swz % 64) / 2; }
__host__ __device__ __forceinline__ int perm32(int rho) { const int n = rho >> 4, i = rho & 15; return 8 * (i >> 2) + 4 * n + (i & 3); }

struct Unit { int pm, pn, e; };
struct Gemm { const bf16_t* A; const bf16_t* Bt; int K; size_t bexp; };

struct DenseOrder {
    int nM, nN, nwg, G, c;
    __device__ void init(int M, int N, int G_, int c_) { nM = M / BM; nN = N / BM; nwg = nM * nN; G = G_; c = c_; }
    __device__ __forceinline__ bool next(int i, Unit& u) const {
        if (c < 0) return false;
        const long L = (long)i * G + c; if (L >= nwg) return false;
        int wgid = (int)L; { const int q = nwg / 8, r = nwg % 8, xcd = wgid % 8, off = wgid / 8; wgid = (xcd < r ? xcd * (q + 1) : r * (q + 1) + (xcd - r) * q) + off; }
        const int nig = 8 * nN, gid = wgid / nig, fm = gid * 8, gsz = (nM - fm) < 8 ? (nM - fm) : 8;
        u.pm = fm + ((wgid % nig) % gsz); u.pn = (wgid % nig) / gsz; u.e = 0; return true;
    }
    __device__ __forceinline__ int tok(const Unit& u, int r) const { return u.pm * BM + r; }
};

template <class Epi, class Sched, bool ALIGN_EPI>
__device__ __forceinline__ void gemm_phase(LAS unsigned char* lds, const Gemm g, const Sched& S, const Epi& E) {
    const int tid = threadIdx.x, wid = __builtin_amdgcn_readfirstlane(tid >> 6), lane = tid & 63, wr = wid >> 2, wc = wid & 3, fr = lane & 15, fq = lane >> 4;
    const int K = g.K, nt = K / BK;
    int Rr[2], Cc[2]; unsigned voffB[2];
#pragma unroll
    for (int i = 0; i < 2; ++i) { int R, C; stage_rc(tid * 16 + i * 8192, R, C); const int Rb = (R & ~31) + perm32(R & 31); Rr[i] = R; Cc[i] = C; voffB[i] = (unsigned)(Rb * K + C) * 2u; }
    const size_t kstep = (size_t)(BK * 2);
    const size_t hstep = (size_t)HALF * K * 2;
    const size_t tstep = 2 * hstep;
    const unsigned ldsw = (unsigned)wid * 1024u;
    const int aoff = lds_byte(wr * 64 + fr, fq * 8), boff = lds_byte(wc * 32 + fr, fq * 8);
#define PG8_SA(b, h) (((b) * 2 + (h)) * HTB)
#define PG8_SB(b, h) ((4 + (b) * 2 + (h)) * HTB)
#define PG8_STAGE(bufoff, gbase, voff) do { _Pragma("unroll") for (int _i = 0; _i < 2; ++_i) \
        __builtin_amdgcn_global_load_lds((const unsigned*)((const char*)(gbase) + (voff)[_i]), (LAS unsigned*)(lds + (bufoff) + ldsw + _i * 8192), 16, 0, 0); } while (0)
#define PG8_LDA(dst, b, h) do { _Pragma("unroll") for (int m = 0; m < 4; ++m) _Pragma("unroll") for (int k = 0; k < 2; ++k) dst[m][k] = *(const LAS bf16x8*)(lds + PG8_SA(b, h) + aoff + m * 2048 + k * 1024); } while (0)
#define PG8_LDB(dst, b, h) do { _Pragma("unroll") for (int n = 0; n < 2; ++n) _Pragma("unroll") for (int k = 0; k < 2; ++k) dst[n][k] = *(const LAS bf16x8*)(lds + PG8_SB(b, h) + boff + n * 2048 + k * 1024); } while (0)
#define PG8_MMA(ai, bj, At, Bt) do { __builtin_amdgcn_s_setprio(1); _Pragma("unroll") for (int m = 0; m < 4; ++m) _Pragma("unroll") for (int n = 0; n < 2; ++n) _Pragma("unroll") for (int k = 0; k < 2; ++k) \
        acc[ai][bj][m][n] = __builtin_amdgcn_mfma_f32_16x16x32_bf16(Bt[n][k], At[m][k], acc[ai][bj][m][n], 0, 0, 0); __builtin_amdgcn_s_setprio(0); } while (0)
#define PG8_WAIT_V(n) asm volatile("s_waitcnt vmcnt(" #n ")" ::: "memory")
#define PG8_WAIT_L(n) asm volatile("s_waitcnt lgkmcnt(" #n ")" ::: "memory")
#define PG8_BAR __builtin_amdgcn_s_barrier()
#define PG8_SCHED __builtin_amdgcn_sched_barrier(0)
#define PG8_SETVO(vo, u) do { _Pragma("unroll") for (int _h = 0; _h < 2; ++_h) _Pragma("unroll") for (int _i = 0; _i < 2; ++_i) \
        vo[_h][_i] = (unsigned)(S.tok(u, _h * HALF + Rr[_i]) * K + Cc[_i]) * 2u; } while (0)
    Unit cur, nxt; int ui = 0;
    if (!S.next(0, cur)) return;
    f32x4 acc[2][2][4][2];
#pragma unroll
    for (int a = 0; a < 2; ++a)
#pragma unroll
        for (int b = 0; b < 2; ++b)
#pragma unroll
            for (int m = 0; m < 4; ++m)
#pragma unroll
                for (int n = 0; n < 2; ++n) acc[a][b][m][n] = (f32x4){0.f, 0.f, 0.f, 0.f};
    bf16x8 At[4][2], B0[2][2], B1[2][2];
    unsigned voC[2][2], voN[2][2];
    PG8_SETVO(voC, cur);
    const char* const cA = (const char*)g.A;
    const char* cB = (const char*)g.Bt + (size_t)cur.e * g.bexp + (size_t)cur.pn * tstep;
    PG8_STAGE(PG8_SB(0, 0), cB, voffB); PG8_STAGE(PG8_SB(0, 1), cB + hstep, voffB); PG8_STAGE(PG8_SA(0, 0), cA, voC[0]); PG8_STAGE(PG8_SA(0, 1), cA, voC[1]);
    if (wr == 1) PG8_BAR;
    PG8_WAIT_V(2); PG8_BAR;
    PG8_STAGE(PG8_SB(1, 0), cB + kstep, voffB); PG8_STAGE(PG8_SA(1, 0), cA + kstep, voC[0]); PG8_STAGE(PG8_SB(1, 1), cB + hstep + kstep, voffB);
    PG8_WAIT_V(6); PG8_BAR;
    for (;;) {
        const bool has_next = S.next(ui + 1, nxt);
        if (has_next) { PG8_SETVO(voN, nxt); }
        else {
#pragma unroll
            for (int h = 0; h < 2; ++h) { voN[h][0] = voC[h][0]; voN[h][1] = voC[h][1]; } }
        const char* nB = has_next ? (const char*)g.Bt + (size_t)nxt.e * g.bexp + (size_t)nxt.pn * tstep : cB;
        for (int t = 0; t < nt; t += 2) {
            const bool last = (t == nt - 2);
            const char* a1 = cA + (size_t)(t + 1) * kstep;
            const char* a2 = last ? cA : cA + (size_t)(t + 2) * kstep; const char* b2 = last ? nB : cB + (size_t)(t + 2) * kstep;
            const char* a3 = a2 + kstep; const char* b3 = b2 + kstep;
            unsigned vo2[2][2];
#pragma unroll
            for (int h = 0; h < 2; ++h) { vo2[h][0] = last ? voN[h][0] : voC[h][0]; vo2[h][1] = last ? voN[h][1] : voC[h][1]; }
            PG8_LDB(B0, 0, 0); PG8_LDB(B1, 0, 1); PG8_SCHED; PG8_LDA(At, 0, 0); PG8_STAGE(PG8_SA(1, 1), a1, voC[1]);
            PG8_WAIT_V(8); PG8_WAIT_L(0); PG8_BAR; PG8_MMA(0, 0, At, B0); PG8_MMA(0, 1, At, B1); PG8_BAR; PG8_SCHED;
            PG8_LDA(At, 0, 1); PG8_STAGE(PG8_SB(0, 0), b2, voffB); PG8_STAGE(PG8_SB(0, 1), b2 + hstep, voffB); PG8_STAGE(PG8_SA(0, 0), a2, vo2[0]);
            PG8_WAIT_V(8); PG8_WAIT_L(0); PG8_BAR; PG8_MMA(1, 0, At, B0); PG8_MMA(1, 1, At, B1); PG8_BAR; PG8_SCHED;
            PG8_LDB(B0, 1, 0); PG8_LDB(B1, 1, 1); PG8_SCHED; PG8_LDA(At, 1, 0); PG8_STAGE(PG8_SA(0, 1), a2, vo2[1]);
            PG8_WAIT_V(8); PG8_WAIT_L(0); PG8_BAR; PG8_MMA(0, 0, At, B0); PG8_MMA(0, 1, At, B1); PG8_BAR; PG8_SCHED;
            PG8_LDA(At, 1, 1); PG8_STAGE(PG8_SB(1, 0), b3, voffB); PG8_STAGE(PG8_SB(1, 1), b3 + hstep, voffB); PG8_STAGE(PG8_SA(1, 0), a3, vo2[0]);
            PG8_WAIT_V(8); PG8_WAIT_L(0); PG8_BAR; PG8_MMA(1, 0, At, B0); PG8_MMA(1, 1, At, B1); PG8_BAR; PG8_SCHED;
        }
        if constexpr (ALIGN_EPI) { if (wr == 0) PG8_BAR; }
        E(acc, cur, wr, wc, fr, fq);
        if (!has_next) break;
#pragma unroll
        for (int a = 0; a < 2; ++a)
#pragma unroll
            for (int b = 0; b < 2; ++b)
#pragma unroll
                for (int m = 0; m < 4; ++m)
#pragma unroll
                    for (int n = 0; n < 2; ++n) acc[a][b][m][n] = (f32x4){0.f, 0.f, 0.f, 0.f};
        cur = nxt; cB = nB; ++ui;
#pragma unroll
        for (int h = 0; h < 2; ++h) { voC[h][0] = voN[h][0]; voC[h][1] = voN[h][1]; }
        if constexpr (ALIGN_EPI) { if (wr == 1) PG8_BAR; }
    }
    PG8_WAIT_V(0);
    if constexpr (!ALIGN_EPI) { if (wr == 0) PG8_BAR; }
    PG8_BAR;
#undef PG8_SA
#undef PG8_SB
#undef PG8_STAGE
#undef PG8_LDA
#undef PG8_LDB
#undef PG8_MMA
#undef PG8_WAIT_V
#undef PG8_WAIT_L
#undef PG8_BAR
#undef PG8_SCHED
#undef PG8_SETVO
}

#define EPI_ROWS_BEGIN const int row0 = u.pm * BM + wr * 64 + fr; const int colw = wc * 32 + 8 * fq; \
    _Pragma("unroll") for (int ai = 0; ai < 2; ++ai) _Pragma("unroll") for (int m = 0; m < 4; ++m) { const size_t row = (size_t)(row0 + ai * HALF + m * 16);
#define EPI_ROWS_END }
__device__ __forceinline__ u32x4 pack8(f32x4 v0, f32x4 v1) { u32x4 w; w.x = cvt_pk_bf16(v0[0], v0[1]); w.y = cvt_pk_bf16(v0[2], v0[3]); w.z = cvt_pk_bf16(v1[0], v1[1]); w.w = cvt_pk_bf16(v1[2], v1[3]); return w; }

struct EpiBf16 {
    bf16_t* O; int ldc;
    __device__ __forceinline__ void operator()(const f32x4 (&acc)[2][2][4][2], const Unit& u, int wr, int wc, int fr, int fq) const {
        EPI_ROWS_BEGIN
            bf16_t* rowp = O + row * ldc + u.pn * BM + colw;
#pragma unroll
            for (int bj = 0; bj < 2; ++bj) *(u32x4*)(rowp + bj * HALF) = pack8(acc[ai][bj][m][0], acc[ai][bj][m][1]);
        EPI_ROWS_END
    }
};
struct EpiProj {
    bf16_t* O; int ldc; float* side;
    __device__ __forceinline__ void operator()(const f32x4 (&acc)[2][2][4][2], const Unit& u, int wr, int wc, int fr, int fq) const {
        const bool sd = (u.pn == 34) && (wc * 32 + 8 * fq < 80);
        EPI_ROWS_BEGIN
            bf16_t* rowp = O + row * ldc + u.pn * BM + colw;
#pragma unroll
            for (int bj = 0; bj < 2; ++bj) *(u32x4*)(rowp + bj * HALF) = pack8(acc[ai][bj][m][0], acc[ai][bj][m][1]);
            if (sd) { float* sp = side + row * 80 + colw; *(f32x4*)sp = acc[ai][0][m][0]; *(f32x4*)(sp + 4) = acc[ai][0][m][1]; }
        EPI_ROWS_END
    }
};
struct EpiGateA {
    bf16_t* O; int ldc; const bf16_t* G; int ldg;
    __device__ __forceinline__ void operator()(const f32x4 (&acc)[2][2][4][2], const Unit& u, int wr, int wc, int fr, int fq) const {
        EPI_ROWS_BEGIN
#pragma unroll
            for (int bj = 0; bj < 2; ++bj) { const int col = u.pn * BM + colw + bj * HALF;
                const u32x4 gw = *(const u32x4*)(G + row * ldg + col);
                f32x4 v0 = acc[ai][bj][m][0], v1 = acc[ai][bj][m][1];
                v0[0] *= sigmoidf_(bf_lo(gw.x)); v0[1] *= sigmoidf_(bf_hi(gw.x)); v0[2] *= sigmoidf_(bf_lo(gw.y)); v0[3] *= sigmoidf_(bf_hi(gw.y));
                v1[0] *= sigmoidf_(bf_lo(gw.z)); v1[1] *= sigmoidf_(bf_hi(gw.z)); v1[2] *= sigmoidf_(bf_lo(gw.w)); v1[3] *= sigmoidf_(bf_hi(gw.w));
                *(u32x4*)(O + row * ldc + col) = pack8(v0, v1); }
        EPI_ROWS_END
    }
};
struct EpiGateB {
    bf16_t* O; int ldc; const bf16_t* G; int ldg;
    __device__ __forceinline__ void operator()(const f32x4 (&acc)[2][2][4][2], const Unit& u, int wr, int wc, int fr, int fq) const {
        EPI_ROWS_BEGIN
#pragma unroll
            for (int bj = 0; bj < 2; ++bj) { const int col = u.pn * BM + colw + bj * HALF;
                const u32x4 gw = *(const u32x4*)(G + row * ldg + col);
                const u32x4 ow = *(const u32x4*)(O + row * ldc + col);
                f32x4 v0 = acc[ai][bj][m][0], v1 = acc[ai][bj][m][1];
                v0[0] = bf_lo(ow.x) + v0[0] * sigmoidf_(bf_lo(gw.x)); v0[1] = bf_hi(ow.x) + v0[1] * sigmoidf_(bf_hi(gw.x));
                v0[2] = bf_lo(ow.y) + v0[2] * sigmoidf_(bf_lo(gw.y)); v0[3] = bf_hi(ow.y) + v0[3] * sigmoidf_(bf_hi(gw.y));
                v1[0] = bf_lo(ow.z) + v1[0] * sigmoidf_(bf_lo(gw.z)); v1[1] = bf_hi(ow.z) + v1[1] * sigmoidf_(bf_hi(gw.z));
                v1[2] = bf_lo(ow.w) + v1[2] * sigmoidf_(bf_lo(gw.w)); v1[3] = bf_hi(ow.w) + v1[3] * sigmoidf_(bf_hi(gw.w));
                *(u32x4*)(O + row * ldc + col) = pack8(v0, v1); }
        EPI_ROWS_END
    }
};
struct EpiResid {
    float* Z; const float* R; int ldc; float alpha;
    __device__ __forceinline__ void operator()(const f32x4 (&acc)[2][2][4][2], const Unit& u, int wr, int wc, int fr, int fq) const {
        EPI_ROWS_BEGIN
#pragma unroll
            for (int bj = 0; bj < 2; ++bj) { const size_t o = row * ldc + u.pn * BM + colw + bj * HALF;
                const f32x4 r0 = *(const f32x4*)(R + o), r1 = *(const f32x4*)(R + o + 4);
                *(f32x4*)(Z + o) = r0 * alpha + acc[ai][bj][m][0]; *(f32x4*)(Z + o + 4) = r1 * alpha + acc[ai][bj][m][1]; }
        EPI_ROWS_END
    }
};
struct EpiSilu {
    bf16_t* O; int ldc;
    __device__ __forceinline__ void operator()(const f32x4 (&acc)[2][2][4][2], const Unit& u, int wr, int wc, int fr, int fq) const {
        EPI_ROWS_BEGIN
            f32x4 v0, v1;
#pragma unroll
            for (int j = 0; j < 4; ++j) { const float a0 = acc[ai][0][m][0][j], a1 = acc[ai][0][m][1][j];
                v0[j] = a0 * sigmoidf_(a0) * acc[ai][1][m][0][j]; v1[j] = a1 * sigmoidf_(a1) * acc[ai][1][m][1][j]; }
            *(u32x4*)(O + row * ldc + u.pn * HALF + colw) = pack8(v0, v1);
        EPI_ROWS_END
    }
};
}
namespace att {
constexpr int D = 128;
constexpr float SCALE = 0.08838834764831845f;
constexpr float THR = 8.f;
constexpr int NW = 8, QBLK = 32, KVBLK = 64, QB = NW * QBLK;
constexpr int SHM_V = KVBLK * D * 2, SHM_K = KVBLK * D * 2;
constexpr int BT_OFF = 2 * SHM_V + 2 * SHM_K + NW * 64 * 4;
constexpr int BT_STRIDE = 132;
constexpr int LDS_BYTES = BT_OFF + 2 * BT_STRIDE * 4;

#define KSWZ(row, colB) ((row) * 256 + ((colB) ^ (((row) & 7) << 4)))
#define SBAR() __builtin_amdgcn_sched_barrier(0)
__device__ __forceinline__ int v_st(int k, int c) { const int kk = (k & ~0xC) | ((k & 4) << 1) | ((k & 8) >> 1); return ((kk >> 3) * 4 + (c >> 5)) * 512 + ((kk & 7) * 32 + (c & 31)) * 2; }
__device__ __forceinline__ int v_rd_base(int lane) { return ((lane & 3) << 3) | (((lane >> 2) & 3) << 6) | (((lane >> 4) & 1) << 5) | (((lane >> 5) & 1) << 8); }
constexpr int v_rd_off(int d0, int ks, int half) { return d0 * 512 + ks * 4096 + half * 2048; }
__device__ __forceinline__ int crow(int r, int hi) { return (r & 3) + 8 * (r >> 2) + 4 * hi; }
__device__ __forceinline__ bf16x8 load8(const bf16_t* p) { return *reinterpret_cast<const bf16x8*>(p); }

__device__ __forceinline__ void mask_causal(f32x16& p0, f32x16& p1, int dq) {
    const float NEG = -__builtin_inff();
#pragma unroll
    for (int r = 0; r < 16; ++r) {
        const int c = (r & 3) + 8 * (r >> 2);
        if (dq - c < 0) p0[r] = NEG;
        if (dq - c - 32 < 0) p1[r] = NEG;
    }
}
__device__ __forceinline__ void add_bias(f32x16& p0, f32x16& p1, int dq, const float* bt) {
#pragma unroll
    for (int g = 0; g < 4; ++g) {
#pragma unroll
        for (int q = 0; q < 4; ++q) { const int r = 4 * g + q; const int c = (r & 3) + 8 * (r >> 2);
            int r0 = dq - c, r1 = dq - c - 32;
            r0 = r0 < 0 ? 0 : (r0 > 128 ? 128 : r0); r1 = r1 < 0 ? 0 : (r1 > 128 ? 128 : r1);
            p0[r] += bt[r0]; p1[r] += bt[r1]; }
        SBAR();
    }
}
__device__ __forceinline__ void mask_sel(f32x16& p0, f32x16& p1, unsigned long long w, int hi) {
    const float NEG = -__builtin_inff();
    const unsigned lo = (unsigned)w >> (4 * hi), hw = (unsigned)(w >> 32) >> (4 * hi);
#pragma unroll
    for (int r = 0; r < 16; ++r) {
        const int c = (r & 3) + 8 * (r >> 2);
        if (!((lo >> c) & 1u)) p0[r] = NEG;
        if (!((hw >> c) & 1u)) p1[r] = NEG;
    }
}
__device__ __forceinline__ void partialSM(f32x16& p0, f32x16& p1, float& m_reg, float& mn, float& alpha) {
    float pmax = p0[0]; for (int r = 1; r < 16; ++r) pmax = fmaxf(pmax, p0[r]); for (int r = 0; r < 16; ++r) pmax = fmaxf(pmax, p1[r]);
    { auto rr = __builtin_amdgcn_permlane32_swap(__float_as_uint(pmax), __float_as_uint(pmax), false, false);
      pmax = fmaxf(__uint_as_float(rr[0]), __uint_as_float(rr[1])); }
    constexpr float C2 = 1.4426950408889634f * SCALE;
    if (__builtin_expect(__all((pmax - m_reg) * SCALE <= THR), 1)) { mn = m_reg; alpha = 1.f; }
    else { mn = fmaxf(m_reg, pmax); alpha = __builtin_amdgcn_exp2f((m_reg - mn) * C2); m_reg = mn; }
    const float mnL = -mn * C2;
    for (int r = 0; r < 16; ++r) p0[r] = fmaf(p0[r], C2, mnL); for (int r = 0; r < 16; ++r) p1[r] = fmaf(p1[r], C2, mnL);
    for (int r = 0; r < 16; ++r) p0[r] = __builtin_amdgcn_exp2f(p0[r]);
}
__device__ __forceinline__ void finishSM(f32x16& p0, f32x16& p1, float alpha, float& l_reg, bf16x8& pa0, bf16x8& pa1, bf16x8& pa2, bf16x8& pa3) {
    for (int r = 0; r < 16; ++r) p1[r] = __builtin_amdgcn_exp2f(p1[r]);
    float ps = 0; for (int r = 0; r < 16; ++r) ps += p0[r]; for (int r = 0; r < 16; ++r) ps += p1[r];
    { auto rr = __builtin_amdgcn_permlane32_swap(__float_as_uint(ps), __float_as_uint(ps), false, false);
      ps = __uint_as_float(rr[0]) + __uint_as_float(rr[1]); }
    l_reg = l_reg * alpha + ps;
#define PK4(P, B_, OUT) do { unsigned a0 = cvt_pk_bf16(P[B_+0], P[B_+1]), a1 = cvt_pk_bf16(P[B_+2], P[B_+3]);                          \
        unsigned b0 = cvt_pk_bf16(P[B_+4], P[B_+5]), b1 = cvt_pk_bf16(P[B_+6], P[B_+7]);                                             \
        auto r0 = __builtin_amdgcn_permlane32_swap(a0, b0, false, false); auto r1 = __builtin_amdgcn_permlane32_swap(a1, b1, false, false); \
        u32x4 w = {r0[0], r1[0], r0[1], r1[1]}; OUT = *reinterpret_cast<bf16x8*>(&w); } while (0)
    PK4(p0, 0, pa0); PK4(p0, 8, pa1); PK4(p1, 0, pa2); PK4(p1, 8, pa3);
#undef PK4
}
template <int KB>
__device__ __forceinline__ void qkt(f32x16& p0, f32x16& p1, const char* K_lds, int r32, int hi, const bf16x8* qr) {
    p0 = f32x16{}; p1 = f32x16{};
    const char* kb[4];
#pragma unroll
    for (int dd = 0; dd < 4; ++dd) kb[dd] = K_lds + KB * SHM_K + KSWZ(r32, (dd * 16 + hi * 8) * 2);
#pragma unroll
    for (int d0 = 0; d0 < 8; ++d0) { const char* a = kb[d0 & 3] + (d0 >> 2) * 128;
        bf16x8 b0 = *reinterpret_cast<const bf16x8*>(a);
        bf16x8 b1 = *reinterpret_cast<const bf16x8*>(a + 32 * 256);
        p0 = __builtin_amdgcn_mfma_f32_32x32x16_bf16(b0, qr[d0], p0, 0, 0, 0);
        p1 = __builtin_amdgcn_mfma_f32_32x32x16_bf16(b1, qr[d0], p1, 0, 0, 0); }
}
template <int VB>
__device__ __forceinline__ void pv_tile(f32x16* o, int vb0, bf16x8 pa0, bf16x8 pa1, bf16x8 pa2, bf16x8 pa3) {
#define TRRD(dst, off) asm volatile("ds_read_b64_tr_b16 %0, %1 offset:%2" : "=&v"(dst) : "v"(vb0), "i"(off) : "memory")
#define PV_D0(d0) do { s16x4 l0, l1, l2, l3, h0, h1, h2, h3; constexpr int b_ = VB * SHM_V + v_rd_off(d0, 0, 0); \
        TRRD(l0, b_); TRRD(h0, b_ + 2048); TRRD(l1, b_ + 4096); TRRD(h1, b_ + 6144); TRRD(l2, b_ + 8192); TRRD(h2, b_ + 10240); TRRD(l3, b_ + 12288); TRRD(h3, b_ + 14336); \
        asm volatile("s_waitcnt lgkmcnt(0)" ::: "memory"); SBAR();   \
        o[d0] = __builtin_amdgcn_mfma_f32_32x32x16_bf16(pa0, (bf16x8){l0[0], l0[1], l0[2], l0[3], h0[0], h0[1], h0[2], h0[3]}, o[d0], 0, 0, 0);   \
        o[d0] = __builtin_amdgcn_mfma_f32_32x32x16_bf16(pa1, (bf16x8){l1[0], l1[1], l1[2], l1[3], h1[0], h1[1], h1[2], h1[3]}, o[d0], 0, 0, 0);   \
        o[d0] = __builtin_amdgcn_mfma_f32_32x32x16_bf16(pa2, (bf16x8){l2[0], l2[1], l2[2], l2[3], h2[0], h2[1], h2[2], h2[3]}, o[d0], 0, 0, 0);   \
        o[d0] = __builtin_amdgcn_mfma_f32_32x32x16_bf16(pa3, (bf16x8){l3[0], l3[1], l3[2], l3[3], h3[0], h3[1], h3[2], h3[3]}, o[d0], 0, 0, 0); } while (0)
    PV_D0(0); PV_D0(1); PV_D0(2); PV_D0(3);
#undef PV_D0
#undef TRRD
}

struct BlockRef { const bf16_t* Q; const bf16_t* K; const bf16_t* V; bf16_t* O; const unsigned long long* sel; int P0; int bt; };
struct Pitch { int ldq, ldkv, ldo; };
struct Seam { bf16x8 qr[8]; bf16x8 st_v0, st_v1, st_k0, st_k1; };

#define ROWU(p, k0) ((p) + (size_t)(k0) * PT.ldkv)
#define VMW() asm volatile("s_waitcnt vmcnt(0)" ::: "memory")
#define VMWN(n) asm volatile("s_waitcnt vmcnt(%0)" :: "i"(n) : "memory")
#define SLOAD_H(Kp, Vp, k0) do { S.st_v0 = load8(ROWU(Vp, k0) + ro0); S.st_v1 = load8(ROWU(Vp, k0) + ro1);              \
                         S.st_k0 = load8(ROWU(Kp, k0) + ro0); S.st_k1 = load8(ROWU(Kp, k0) + ro1); } while (0)
#define SWRITE_HK(bf) do { *(bf16x8*)(K_lds + (bf) * SHM_K + kws) = S.st_k0; *(bf16x8*)(K_lds + (bf) * SHM_K + kws + 32 * 256) = S.st_k1; } while (0)
#define SWRITE_HV(bf) do { *(bf16x8*)(V_lds + (bf) * SHM_V + vst0) = S.st_v0; *(bf16x8*)(V_lds + (bf) * SHM_V + vst1) = S.st_v1; } while (0)
#define SWRITE_H(bf) do { SWRITE_HV(bf); SWRITE_HK(bf); } while (0)
__device__ __forceinline__ void prime(const BlockRef& cur, const Pitch& PT, char* lds, Seam& S) {
    const int tid = threadIdx.x, wid = __builtin_amdgcn_readfirstlane(tid >> 6), lane = tid & 63, r32 = lane & 31, hi = lane >> 5;
    const int sr = tid >> 4, sc = (tid & 15) * 8, kws = KSWZ(sr, sc * 2); char* K_lds = lds + 2 * SHM_V;
    const unsigned ro0 = (unsigned)(sr * PT.ldkv + sc), ro1 = (unsigned)((32 + sr) * PT.ldkv + sc), qo = (unsigned)((wid * QBLK + r32) * PT.ldq + hi * 8);
#pragma unroll
    for (int d0 = 0; d0 < 8; ++d0) S.qr[d0] = load8(cur.Q + qo + d0 * 16);
    SLOAD_H(cur.K, cur.V, 0); VMW(); SWRITE_HK(0);
    __syncthreads();
}
template <bool BIAS, bool SEL>
__device__ __forceinline__ void block(const BlockRef& cur, const BlockRef& nxt, int skv, const Pitch& PT, char* lds, Seam& S) {
    const int tid = threadIdx.x, wid = __builtin_amdgcn_readfirstlane(tid >> 6), lane = tid & 63, r32 = lane & 31, hi = lane >> 5;
    int j_hi = (cur.P0 + QB - 1) / KVBLK + 1; if (j_hi > skv / KVBLK) j_hi = skv / KVBLK;
    const int NT = j_hi;
    const int qlo = cur.P0 + wid * QBLK, qm = qlo + r32 - 4 * hi;
    char* V_lds = lds; char* K_lds = lds + 2 * SHM_V;
    float* ws = (float*)(lds + 2 * SHM_V + 2 * SHM_K) + wid * 64; float* li_l = ws, * al_l = ws + 32;
    const float* btab = (const float*)(lds + BT_OFF) + cur.bt * BT_STRIDE;
    const unsigned selo = (unsigned)((wid * QBLK + r32) * 32);
    unsigned long long selw = 0ull;
    float m_reg = -1e30f, l_reg = 0; f32x16 o[4] = {};
    const int sr = tid >> 4, sc = (tid & 15) * 8, vst0 = v_st(sr, sc), vst1 = v_st(32 + sr, sc), kws = KSWZ(sr, sc * 2);
    const int vb0 = (int)(uintptr_t)V_lds + v_rd_base(lane);
    const unsigned ro0 = (unsigned)(sr * PT.ldkv + sc), ro1 = (unsigned)((32 + sr) * PT.ldkv + sc), qo = (unsigned)((wid * QBLK + r32) * PT.ldq + hi * 8);
    const bf16_t* Kh = cur.K; const bf16_t* Vh = cur.V;
#define RESC(a) do { if (__any((a) < 1.f)) { if (hi == 0) al_l[r32] = (a); asm volatile("s_waitcnt lgkmcnt(0)" ::: "memory");              \
                     for (int d_ = 0; d_ < 4; ++d_) for (int r = 0; r < 16; ++r) o[d_][r] *= al_l[crow(r, hi)]; } } while (0)
#define KBASE(t) ((t) * KVBLK)
#define SELLD(t) do { if (SEL) selw = (cur.sel + (t))[selo]; } while (0)
#define MASKT(P0_, P1_, t) do { const int kb_ = KBASE(t); const int dq_ = qm - kb_; \
        if (kb_ + KVBLK - 1 > qlo) mask_causal(P0_, P1_, dq_); \
        if (BIAS && kb_ + KVBLK - 1 + 128 > qlo) add_bias(P0_, P1_, dq_, btab); \
        if (SEL) mask_sel(P0_, P1_, selw, hi); } while (0)
    constexpr int NQL = 8;
#define SEAM_K0() do { VMWN(NQL); SWRITE_HK(0); SBAR(); } while (0)
    f32x16 pA0, pA1, pB0, pB1; float mnA, mnB, alA, alB; bf16x8 pa0, pa1, pa2, pa3;
    SWRITE_HV(0); SBAR();
    SELLD(0);
    if (NT > 1) { SLOAD_H(Kh, Vh, KBASE(1)); }
    SBAR(); qkt<0>(pA0, pA1, K_lds, r32, hi, S.qr);
    MASKT(pA0, pA1, 0); partialSM(pA0, pA1, m_reg, mnA, alA);
    if (NT > 1) { VMW(); SWRITE_H(1); }
    __syncthreads();
#define HALF_STEP(PX0, PX1, mnX, alX, PY0, PY1, alY, t, KB, VB, SB) do {                                                      \
        SBAR(); SELLD(t); qkt<KB>(PX0, PX1, K_lds, r32, hi, S.qr);                                             \
        finishSM(PY0, PY1, alY, l_reg, pa0, pa1, pa2, pa3); SBAR();                                                           \
        if ((t) + 1 < NT) { SLOAD_H(Kh, Vh, KBASE((t) + 1)); SBAR(); }                                               \
        pv_tile<VB>(o, vb0, pa0, pa1, pa2, pa3); MASKT(PX0, PX1, (t)); partialSM(PX0, PX1, m_reg, mnX, alX);                                        \
        __syncthreads();                                                                                                      \
        if ((t) + 1 < NT) { VMW(); SWRITE_H(SB); }                                                                          \
        RESC(alX); __syncthreads(); } while (0)
    for (int t = 1; t + 1 < NT; t += 2) {
        HALF_STEP(pB0, pB1, mnB, alB, pA0, pA1, alA, t, 1, 0, 0);
        HALF_STEP(pA0, pA1, mnA, alA, pB0, pB1, alB, t + 1, 0, 1, 1);
    }
    const bool even = (NT & 1) == 0;
    if (even) { SBAR(); SELLD(NT - 1); qkt<1>(pB0, pB1, K_lds, r32, hi, S.qr); SBAR(); }
    SLOAD_H(nxt.K, nxt.V, 0); SBAR();
    { int t2 = threadIdx.x; asm volatile("" : "+v"(t2));
      const unsigned qo2 = (unsigned)((((t2 >> 6) * QBLK) + (t2 & 31)) * PT.ldq + ((t2 >> 5) & 1) * 8);
#pragma unroll
      for (int d0 = 0; d0 < 8; ++d0) S.qr[d0] = load8(nxt.Q + qo2 + d0 * 16); }
    SBAR();
    finishSM(pA0, pA1, alA, l_reg, pa0, pa1, pa2, pa3); SBAR();
    pv_tile<0>(o, vb0, pa0, pa1, pa2, pa3);
    if (even) { MASKT(pB0, pB1, NT - 1); partialSM(pB0, pB1, m_reg, mnB, alB); __syncthreads(); RESC(alB);
        finishSM(pB0, pB1, alB, l_reg, pa0, pa1, pa2, pa3); SBAR(); pv_tile<1>(o, vb0, pa0, pa1, pa2, pa3); }
    SBAR(); SEAM_K0();
    if (hi == 0) li_l[r32] = l_reg; asm volatile("s_waitcnt lgkmcnt(0)" ::: "memory");
    float rli[16];
#pragma unroll
    for (int r = 0; r < 16; ++r) rli[r] = __builtin_amdgcn_rcpf(li_l[crow(r, hi)]);
    bf16_t* Ow = cur.O + (size_t)(wid * QBLK) * PT.ldo;
    int hi4 = 4 * hi; asm volatile("" : "+v"(hi4));
#pragma unroll
    for (int r = 0; r < 16; ++r) { const unsigned roff = (unsigned)((r & 3) + 8 * (r >> 2) + hi4) * (unsigned)PT.ldo + r32;
#pragma unroll
        for (int d0 = 0; d0 < 4; ++d0) { const float v = o[d0][r] * rli[r];
            const float vn = __shfl_xor(v, 1);
            if ((r32 & 1) == 0) *(unsigned*)(Ow + roff + d0 * 32) = cvt_pk_bf16(v, vn); } }
    __syncthreads();
#undef RESC
#undef KBASE
#undef SELLD
#undef MASKT
#undef SEAM_K0
#undef HALF_STEP
}
#undef ROWU
#undef VMW
#undef VMWN
#undef SLOAD_H
#undef SWRITE_HK
#undef SWRITE_HV
#undef SWRITE_H
}
constexpr int NB = 4, T = 2048, DM = 2048, M = NB * T;
constexpr int NPROJ = 12880, LDP = 13056;
constexpr int C_QD = 0, C_KD = 2048, C_VD = 4096, C_QS = 6144, C_CKV = 7168, C_QI = 7680, C_KI = 8704, C_WI = 8768, C_GD = 8784, C_GS = 10832;
constexpr int NE = 64, NEX = 65, EDIM = 512, TOPK = 8;
constexpr int MAXTILES = 352, MAXROWS = MAXTILES * 256;
constexpr float LN_EPS = 1e-5f;
constexpr float DN_ALPHA = 1.189207115002721f;
constexpr float LAMBDA_INIT = 0.2f;
constexpr int NWAVES = 8;

constexpr size_t MiB = 1u << 20;
constexpr size_t WS_CTL = 0, CTL_ZERO_BYTES = 1 * MiB;
constexpr size_t WS_IDX = 1 * MiB;
constexpr size_t WS_WI = 2 * MiB;
constexpr size_t WS_KIB = 3 * MiB;
constexpr size_t WS_SIDE = 4 * MiB;
constexpr size_t WS_TOKL = 7 * MiB;
constexpr size_t WS_SELM = 9 * MiB;
constexpr size_t WS_WKVS = 12 * MiB;
constexpr size_t WS_WPD = 14 * MiB, WS_WPS = 22 * MiB, WS_WMO = 26 * MiB, WS_WXQ = 34 * MiB, WS_WXKV = 36 * MiB, WS_WXO = 40 * MiB;
constexpr size_t WS_MEMB = 42 * MiB, WS_CB = 46 * MiB, WS_HB = 54 * MiB, WS_MERGED = 86 * MiB, WS_OS = 118 * MiB, WS_KVS = 134 * MiB;
constexpr size_t WS_XQ = 134 * MiB, WS_XKV = 142 * MiB, WS_XO = 144 * MiB;
constexpr size_t WS_ODRAW = 166 * MiB, WS_OD = 230 * MiB;
constexpr size_t WS_W2T = 262 * MiB, WS_W13T = 392 * MiB;
constexpr size_t WS_WINT = 652 * MiB, WS_XB = 703 * MiB, WS_PROJ = 735 * MiB, WS_END = 939 * MiB;
constexpr size_t WS_OUTROWS = 392 * MiB;
constexpr size_t WS_ACT = 744 * MiB;
static_assert(WS_OUTROWS + (size_t)MAXROWS * 2048 * 2 <= WS_ACT && WS_ACT + (size_t)MAXROWS * 512 * 2 <= WS_END, "late overlays");
static_assert(WS_PROJ + (size_t)M * LDP * 2 <= WS_END && WS_WINT + (size_t)LDP * 2048 * 2 <= WS_XB, "early region");
constexpr int CW_BAR = 4096;
constexpr int CW_CNT = 16384;

constexpr int RING_OFF = 0, RING_BYTES = 131072;
constexpr int LDSCTL_OFF = RING_BYTES, MISC_OFF = LDSCTL_OFF + 320;
constexpr int LDS_BYTES = 147456;

#define RLX_AGENT __ATOMIC_RELAXED, __HIP_MEMORY_SCOPE_AGENT
#define LDS_WAIT() asm volatile("s_waitcnt lgkmcnt(0)" ::: "memory")
#define VM_WAIT() asm volatile("s_waitcnt vmcnt(0)" ::: "memory")

#define XB_TMO      128
#define XB_XCNT(j)  (256  + 64 * (j))
#define XB_XSUB(j)  (1280 + 64 * (j))
#define XB_XGEN(j)  (2304 + 64 * (j))
#define XB_TOP      3328
#define XB_TOPGEN   3392
#define XCD_BAR_WORDS 3456
#define XB_SPIN_CAP (1u << 22)
__device__ __forceinline__ unsigned xb_ld(unsigned* p)              { return __hip_atomic_load(p, __ATOMIC_RELAXED, __HIP_MEMORY_SCOPE_AGENT); }
__device__ __forceinline__ unsigned xb_add(unsigned* p, unsigned v) { return __hip_atomic_fetch_add(p, v, __ATOMIC_RELAXED, __HIP_MEMORY_SCOPE_AGENT); }
__device__ __forceinline__ unsigned xb_xcc_id() { return (unsigned)__builtin_amdgcn_s_getreg((3 << 11) | 20) & 0xFu; }
#define XB_SPIN(cond, bar) do { unsigned _sp = 0; while (cond) { __builtin_amdgcn_s_sleep(1); \
    if ((++_sp & 255u) == 0u) { if (xb_ld(&(bar)[XB_TMO])) break; if (_sp > XB_SPIN_CAP) { atomicAdd(&(bar)[XB_TMO], 1u); break; } } } } while (0)
struct XcdBarrier { unsigned* bar; unsigned x; volatile LAS unsigned* st; };
__device__ __forceinline__ XcdBarrier xcd_barrier_post(unsigned* bar, volatile LAS unsigned* st) {
    XcdBarrier b; b.bar = bar; b.x = xb_xcc_id(); b.st = st;
    if (threadIdx.x == 0) (void)xb_add(&bar[XB_XCNT(b.x)], 1u);
    return b;
}
__device__ __forceinline__ void xcd_barrier_complete(unsigned* bar, unsigned x, unsigned& nloc, unsigned& nx) {
    const unsigned G = gridDim.x * gridDim.y * gridDim.z;
    unsigned sum, cnt, mine, sp = 0u;
    for (;;) {
        sum = 0u; cnt = 0u; mine = 0u;
#pragma unroll
        for (unsigned j = 0; j < 16; ++j) { const unsigned c = xb_ld(&bar[XB_XCNT(j)]); sum += c; cnt += (c > 0u) ? 1u : 0u; mine = (j == x) ? c : mine; }
        if (sum == G) break;
        __builtin_amdgcn_s_sleep(1);
        if ((++sp & 255u) == 0u) { if (xb_ld(&bar[XB_TMO])) break; if (sp > XB_SPIN_CAP) { atomicAdd(&bar[XB_TMO], 1u); break; } }
    }
    nloc = mine > 0u ? mine : 1u; nx = cnt > 0u ? cnt : 1u;
}
__device__ __forceinline__ void xcd_barrier(const XcdBarrier& b) {
    asm volatile("s_waitcnt vmcnt(0)" ::: "memory");
    __syncthreads();
    if (threadIdx.x == 0) {
        unsigned* bar = b.bar;
        __builtin_amdgcn_s_waitcnt(0);
        unsigned nloc = b.st[0], nx = b.st[1];
        if (nloc == 0u) { xcd_barrier_complete(bar, b.x, nloc, nx); b.st[0] = nloc; b.st[1] = nx; }
        const unsigned old = xb_add(&bar[XB_XSUB(b.x)], 1u);
        const unsigned gen = old / nloc;
        if (old + 1u == (gen + 1u) * nloc) {
            __builtin_amdgcn_fence(__ATOMIC_RELEASE, "agent");
            asm volatile("s_waitcnt vmcnt(0)" ::: "memory");
            const unsigned og = xb_add(&bar[XB_TOP], 1u);
            const unsigned tg = og / nx;
            if (og + 1u == (tg + 1u) * nx) xb_add(&bar[XB_TOPGEN], 1u);
            else XB_SPIN(xb_ld(&bar[XB_TOPGEN]) == tg, bar);
            __builtin_amdgcn_fence(__ATOMIC_ACQUIRE, "agent");
            xb_add(&bar[XB_XGEN(b.x)], 1u);
            asm volatile("s_waitcnt vmcnt(0)" ::: "memory");
        } else {
            XB_SPIN(xb_ld(&bar[XB_XGEN(b.x)]) == gen, bar);
            __builtin_amdgcn_fence(__ATOMIC_ACQUIRE, "agent");
            asm volatile("s_waitcnt vmcnt(0)" ::: "memory");
        }
    }
    __syncthreads();
}

struct Args { const float* in[32]; float* out; unsigned char* ws; int ph_lo, ph_hi; };
struct Frame {
    LAS unsigned char* lds; char* ldsg;
    unsigned* ctl;
    int tid, lane, wave, vcu, G;
    const __attribute__((address_space(4))) char* ka;
    float* out; unsigned char* ws;
};
#define INP(i) (*(const float* const __attribute__((address_space(4)))*)(F.ka + 8 * (i)))
#define WSP(T_, off) ((T_*)(F.ws + (off)))

__device__ __forceinline__ void p0_transpose_item(const float* src, int ldn, int nvalid, int k0, int n0, bf16_t* dst, size_t drow0, int Kd, LAS float* scr, int lane) {
    int nn = n0 + (lane & 31); nn = nn < nvalid ? nn : nvalid - 1;
#pragma unroll 8
    for (int i = 0; i < 32; ++i) { const int kk = 2 * i + (lane >> 5); scr[kk * 33 + (lane & 31)] = src[(size_t)(k0 + kk) * ldn + nn]; }
    LDS_WAIT(); asm volatile("" ::: "memory");
    const int c = lane & 7;
#pragma unroll
    for (int j = 0; j < 4; ++j) { const int n = (lane >> 3) + 8 * j; const LAS float* s = scr + (8 * c) * 33 + n;
        u32x4 o; o.x = cvt_pk_bf16(s[0 * 33], s[1 * 33]); o.y = cvt_pk_bf16(s[2 * 33], s[3 * 33]); o.z = cvt_pk_bf16(s[4 * 33], s[5 * 33]); o.w = cvt_pk_bf16(s[6 * 33], s[7 * 33]);
        *(u32x4*)(dst + (drow0 + n) * Kd + k0 + 8 * c) = o; }
    LDS_WAIT(); asm volatile("" ::: "memory");
}
__device__ __forceinline__ void cvt_row(const float* s, bf16_t* d, int n, int lane) {
    for (int i = lane * 8; i < n; i += 512) { const f32x4 a = *(const f32x4*)(s + i), b = *(const f32x4*)(s + i + 4); *(u32x4*)(d + i) = pg8::pack8(a, b); }
}
__device__ __forceinline__ void p0_prologue(Frame& F) {
    LAS float* scr = (LAS float*)(F.lds + RING_OFF + F.wave * 16384);
    const int gw = F.vcu * NWAVES + F.wave, NGW = F.G * NWAVES, lane = F.lane;
    constexpr int I_WIN = 32 * 403, I_PD = 32 * 64, I_PS = 16 * 64, I_MO = 32 * 64, I_XQ = 32 * 16, I_XKV = 32 * 32, I_XO = 8 * 64, I_UV = 8 * 32, I_UK = 1024;
    constexpr int I_E = 512, I_EXP = 3 * I_E * NEX, I_X = M, I_MEM = 1024;
    constexpr int NITEMS = I_EXP + I_WIN + I_PD + I_PS + I_MO + I_XQ + I_XKV + I_XO + I_UV + I_UK + I_X + I_MEM;
    for (int it = gw; it < NITEMS; it += NGW) {
        int r = it;
        if (r < I_EXP) {
            const int e = r / (3 * I_E), q = r % (3 * I_E), which = q / I_E, s = q % I_E;
            if (which < 2) {
                const float* src = e < NE ? INP(which == 0 ? 24 : 25) + (size_t)e * 2048 * 512 : INP(which == 0 ? 27 : 28);
                const int kb = s / 16, nb = s % 16, n0 = nb * 32;
                p0_transpose_item(src, 512, 512, kb * 64, n0, WSP(bf16_t, WS_W13T) + (size_t)e * 1024 * 2048, (size_t)((n0 >> 7) * 256 + which * 128 + (n0 & 127)), 2048, scr, lane);
            } else {
                const float* src = e < NE ? INP(26) + (size_t)e * 512 * 2048 : INP(29);
                const int kb = s / 64, nb = s % 64;
                p0_transpose_item(src, 2048, 2048, kb * 64, nb * 32, WSP(bf16_t, WS_W2T) + (size_t)e * 2048 * 512, (size_t)(nb * 32), 512, scr, lane);
            }
            continue; }
        r -= I_EXP;
        if (r < I_WIN) { const int kb = r / 403, nb = r % 403; p0_transpose_item(INP(4), NPROJ, NPROJ, kb * 64, nb * 32, WSP(bf16_t, WS_WINT), (size_t)(nb * 32), 2048, scr, lane); continue; } r -= I_WIN;
        if (r < I_PD) { const int kb = r / 64, nb = r % 64; p0_transpose_item(INP(12), 2048, 2048, kb * 64, nb * 32, WSP(bf16_t, WS_WPD), (size_t)(nb * 32), 2048, scr, lane); continue; } r -= I_PD;
        if (r < I_PS) { const int kb = r / 64, nb = r % 64; p0_transpose_item(INP(13), 2048, 2048, kb * 64, nb * 32, WSP(bf16_t, WS_WPS), (size_t)(nb * 32), 1024, scr, lane); continue; } r -= I_PS;
        if (r < I_MO) { const int kb = r / 64, nb = r % 64; p0_transpose_item(INP(14), 2048, 2048, kb * 64, nb * 32, WSP(bf16_t, WS_WMO), (size_t)(nb * 32), 2048, scr, lane); continue; } r -= I_MO;
        if (r < I_XQ) { const int kb = r / 16, nb = r % 16; p0_transpose_item(INP(17), 512, 512, kb * 64, nb * 32, WSP(bf16_t, WS_WXQ), (size_t)(nb * 32), 2048, scr, lane); continue; } r -= I_XQ;
        if (r < I_XKV) { const int kb = r / 32, nb = r % 32; p0_transpose_item(INP(18), 1024, 1024, kb * 64, nb * 32, WSP(bf16_t, WS_WXKV), (size_t)(nb * 32), 2048, scr, lane); continue; } r -= I_XKV;
        if (r < I_XO) { const int kb = r / 64, nb = r % 64; p0_transpose_item(INP(19), 2048, 2048, kb * 64, nb * 32, WSP(bf16_t, WS_WXO), (size_t)(nb * 32), 512, scr, lane); continue; } r -= I_XO;
        if (r < I_UV) { const int h = r / 32, s = r % 32, kb = s / 4, nb = s % 4;
            p0_transpose_item(INP(11) + (size_t)h * 512 * 128, 128, 128, kb * 64, nb * 32, WSP(bf16_t, WS_WKVS), (size_t)(1024 + h * 128 + nb * 32), 512, scr, lane); continue; } r -= I_UV;
        if (r < I_UK) { cvt_row(INP(10) + (size_t)r * 512, WSP(bf16_t, WS_WKVS) + (size_t)r * 512, 512, lane); continue; } r -= I_UK;
        if (r < I_X) { cvt_row(INP(0) + (size_t)r * DM, WSP(bf16_t, WS_XB) + (size_t)r * DM, DM, lane); continue; } r -= I_X;
        cvt_row(INP(1) + (size_t)r * DM, WSP(bf16_t, WS_MEMB) + (size_t)r * DM, DM, lane);
    }
}

__device__ __forceinline__ void p2_token_norms(Frame& F) {
    const int gw = F.vcu * NWAVES + F.wave, NGW = F.G * NWAVES, lane = F.lane;
    const bf16_t* proj = WSP(bf16_t, WS_PROJ); const float* side = WSP(float, WS_SIDE);
    const float* kvg = INP(9); const float* kg = INP(7); const float* kb = INP(8);
    for (int t = gw; t < M; t += NGW) {
        const u32x4 w = *(const u32x4*)(proj + (size_t)t * LDP + C_CKV + lane * 8);
        float v[8] = {bf_lo(w.x), bf_hi(w.x), bf_lo(w.y), bf_hi(w.y), bf_lo(w.z), bf_hi(w.z), bf_lo(w.w), bf_hi(w.w)};
        float ss = 0.f;
#pragma unroll
        for (int j = 0; j < 8; ++j) ss += v[j] * v[j];
        const float rstd = 1.0f / sqrtf(wave_sum(ss) * (1.0f / 512.0f) + LN_EPS);
        const f32x4 g0 = *(const f32x4*)(kvg + lane * 8), g1 = *(const f32x4*)(kvg + lane * 8 + 4);
        f32x4 o0 = {v[0] * rstd * g0[0], v[1] * rstd * g0[1], v[2] * rstd * g0[2], v[3] * rstd * g0[3]};
        f32x4 o1 = {v[4] * rstd * g1[0], v[5] * rstd * g1[1], v[6] * rstd * g1[2], v[7] * rstd * g1[3]};
        *(u32x4*)(WSP(bf16_t, WS_CB) + (size_t)t * 512 + lane * 8) = pg8::pack8(o0, o1);
        const float kv = side[(size_t)t * 80 + lane];
        const float mu = wave_sum(kv) * (1.0f / 64.0f); const float dv = kv - mu;
        const float var = wave_sum(dv * dv) * (1.0f / 64.0f);
        const float kn = dv * (1.0f / sqrtf(var + LN_EPS)) * kg[lane] + kb[lane];
        const float kn2 = __shfl_xor(kn, 1);
        if ((lane & 1) == 0) *(unsigned*)(WSP(bf16_t, WS_KIB) + (size_t)t * 64 + lane) = cvt_pk_bf16(kn, kn2);
        if (lane < 16) WSP(float, WS_WI)[(size_t)t * 16 + lane] = side[(size_t)t * 80 + 64 + lane] * (1.0f / 32.0f);
    }
}

__device__ __forceinline__ unsigned fkey(float f) { const unsigned u = __builtin_bit_cast(unsigned, f); return (u & 0x80000000u) ? ~u : (u | 0x80000000u); }
__device__ __forceinline__ void p3_indexer(Frame& F) {
    const int lane = F.lane, wave = F.wave, c = lane & 31, hi = lane >> 5;
    const bf16_t* proj = WSP(bf16_t, WS_PROJ); const bf16_t* kib = WSP(bf16_t, WS_KIB); const float* wi = WSP(float, WS_WI);
    float* scr = F.out + ((size_t)blockIdx.x * NWAVES + wave) * (4 * 2048);
    unsigned long long* selm = WSP(unsigned long long, WS_SELM);
    for (int unit = blockIdx.x; unit < NB * 64; unit += F.G) {
        const int b = unit >> 6, y = unit & 63;
        const int tile = (wave < 4) ? y : 127 - y;
        const int t0 = tile * 16 + (wave & 3) * 4;
        bf16x8 af[2][4]; float wv[2][16];
        const int atok = (c >> 2) & 1, ahead = (c & 3) + 4 * (c >> 3);
#pragma unroll
        for (int mb = 0; mb < 2; ++mb) {
            const bf16_t* qp = proj + (size_t)(b * T + t0 + 2 * mb + atok) * LDP + C_QI + ahead * 64 + hi * 8;
#pragma unroll
            for (int ks = 0; ks < 4; ++ks) af[mb][ks] = *(const bf16x8*)(qp + ks * 16);
            const float* wp = wi + (size_t)(b * T + t0 + 2 * mb + hi) * 16;
#pragma unroll
            for (int r = 0; r < 16; ++r) wv[mb][r] = wp[(r & 3) + 4 * (r >> 2)];
        }
        const int nkb = (t0 + 3) / 32 + 1;
        for (int kb = 0; kb < nkb; ++kb) {
            const bf16_t* kp = kib + (size_t)(b * T + kb * 32 + c) * 64 + hi * 8;
            bf16x8 bfr[4];
#pragma unroll
            for (int ks = 0; ks < 4; ++ks) bfr[ks] = *(const bf16x8*)(kp + ks * 16);
#pragma unroll
            for (int mb = 0; mb < 2; ++mb) {
                f32x16 acc = {};
#pragma unroll
                for (int ks = 0; ks < 4; ++ks) acc = __builtin_amdgcn_mfma_f32_32x32x16_bf16(af[mb][ks], bfr[ks], acc, 0, 0, 0);
                float s = 0.f;
#pragma unroll
                for (int r = 0; r < 16; ++r) s = fmaf(fmaxf(acc[r], 0.f), wv[mb][r], s);
                scr[(2 * mb + hi) * 2048 + kb * 32 + c] = s;
            }
        }
        VM_WAIT();
        for (int q = 0; q < 4; ++q) {
            const int t = t0 + q, nvalid = t + 1;
            const float* row = scr + q * 2048;
            unsigned key[32];
#pragma unroll
            for (int j = 0; j < 32; ++j) { const int k = j * 64 + lane; float v = 0.f; if (k < nvalid) v = __builtin_nontemporal_load(row + k); key[j] = (k < nvalid) ? fkey(v) : 0u; }
            unsigned thr = 1u;
            if (nvalid > 256) {
                thr = 0u;
                for (int bit = 31; bit >= 0; --bit) {
                    const unsigned cand = thr | (1u << bit); int cnt = 0;
#pragma unroll
                    for (int j = 0; j < 32; ++j) cnt += (key[j] >= cand) ? 1 : 0;
#pragma unroll
                    for (int o = 1; o < 64; o <<= 1) cnt += __shfl_xor(cnt, o);
                    if (cnt >= 256) thr = cand;
                }
            }
            unsigned mlo = 0u, mhi = 0u;
#pragma unroll
            for (int j = 0; j < 32; ++j) { const unsigned long long bm = __ballot(key[j] >= thr && key[j] != 0u);
                asm volatile("v_writelane_b32 %0, %2, %4\n\tv_writelane_b32 %1, %3, %4" : "+v"(mlo), "+v"(mhi) : "s"((unsigned)bm), "s"((unsigned)(bm >> 32)), "n"(j)); }
            if (lane < 32) selm[(size_t)(b * T + t) * 32 + lane] = ((unsigned long long)mhi << 32) | mlo;
        }
    }
}

__device__ __forceinline__ void write_bias_table(Frame& F, const float* table, int col, int which) {
    float* bt = (float*)(F.ldsg + att::BT_OFF) + which * att::BT_STRIDE;
    int rel = F.tid; asm volatile("" : "+v"(rel));
    if (rel <= 128) {
        int bucket;
        if (rel < 16) bucket = rel;
        else { const float nf = (float)rel; int lg = 16 + (int)(logf(nf / 16.0f) / 2.0794415416798357f * 16.0f); bucket = lg < 31 ? lg : 31; }
        bt[rel] = (table[bucket * 16 + col] - table[31 * 16 + col]) * (1.0f / att::SCALE);
    }
}
__device__ __forceinline__ att::BlockRef self_ref(Frame& F, int job, int qb) {
    att::BlockRef r; const bf16_t* proj = WSP(bf16_t, WS_PROJ);
    if (job < 128) { const int b = job >> 5, h = (job >> 2) & 7, cmap = (job >> 1) & 1, half = job & 1;
        const size_t base = (size_t)b * T * LDP;
        r.Q = proj + base + (size_t)qb * 256 * LDP + C_QD + h * 256 + cmap * 128;
        r.K = proj + base + C_KD + h * 256 + cmap * 128;
        r.V = proj + base + C_VD + h * 256 + half * 128;
        r.O = WSP(bf16_t, WS_ODRAW) + (size_t)cmap * M * 2048 + (size_t)(b * T + qb * 256) * 2048 + h * 256 + half * 128;
        r.sel = nullptr; r.bt = h;
    } else { const int j = job - 128, b = j >> 3, h = j & 7;
        r.Q = proj + (size_t)(b * T + qb * 256) * LDP + C_QS + h * 128;
        r.K = WSP(bf16_t, WS_KVS) + (size_t)b * T * 2048 + h * 128;
        r.V = WSP(bf16_t, WS_KVS) + (size_t)b * T * 2048 + 1024 + h * 128;
        r.O = WSP(bf16_t, WS_OS) + (size_t)(b * T + qb * 256) * 1024 + h * 128;
        r.sel = WSP(unsigned long long, WS_SELM) + (size_t)(b * T + qb * 256) * 32; r.bt = 8 + h;
    }
    r.P0 = qb * 256;
    return r;
}
__device__ __forceinline__ att::BlockRef decode_self(Frame& F, int job_lo, int L_, int pass_, int& col) {
    const int job = job_lo + (L_ >> 2), y = L_ & 3; att::BlockRef r = self_ref(F, job, pass_ ? 7 - y : y); col = r.bt; return r; }
__device__ __forceinline__ att::BlockRef decode_cross(Frame& F, int L_) { const int b = L_ >> 5, h = (L_ >> 3) & 3, qb = L_ & 7; att::BlockRef r;
    r.Q = WSP(bf16_t, WS_XQ) + (size_t)(b * T + qb * 256) * 512 + h * 128;
    r.K = WSP(bf16_t, WS_XKV) + (size_t)b * 256 * 1024 + h * 128;
    r.V = WSP(bf16_t, WS_XKV) + (size_t)b * 256 * 1024 + 512 + h * 128;
    r.O = WSP(bf16_t, WS_XO) + (size_t)(b * T + qb * 256) * 512 + h * 128;
    r.sel = nullptr; r.bt = 0; r.P0 = 4096; return r; }
template <bool SEL>
__device__ __forceinline__ void attn_self_phase(Frame& F, int job_lo, int job_hi) {
    const int nitems = (job_hi - job_lo) * 4, stride = F.G;
    int L = blockIdx.x; if (L >= nitems) return;
    const float* table = INP(3);
    int pass = 0, slot = 0;
    int col; att::BlockRef cur = decode_self(F, job_lo, L, 0, col); cur.bt = slot;
    const att::Pitch PT{LDP, SEL ? 2048 : LDP, SEL ? 1024 : 2048};
    write_bias_table(F, table, col, slot);
    att::Seam S;
    att::prime(cur, PT, F.ldsg, S);
    for (;;) {
        const bool more_pass = pass == 0, more_item = L + stride < nitems, last = !more_pass && !more_item;
        int passn = pass + 1, Ln = L;
        if (!more_pass) { passn = 0; Ln = more_item ? L + stride : L; }
        att::BlockRef nxt = cur; int coln = col;
        if (!last) { nxt = decode_self(F, job_lo, Ln, passn, coln); nxt.bt = slot ^ 1; write_bias_table(F, table, coln, slot ^ 1); }
        att::block<true, SEL>(cur, nxt, T, PT, F.ldsg, S);
        if (last) break;
        cur = nxt; pass = passn; L = Ln; slot ^= 1; col = coln;
    }
}
__device__ __forceinline__ void attn_cross_phase(Frame& F) {
    const int nitems = NB * 4 * 8, stride = F.G;
    int L = blockIdx.x; if (L >= nitems) return;
    att::BlockRef cur = decode_cross(F, L);
    const att::Pitch PT{512, 1024, 512};
    att::Seam S;
    att::prime(cur, PT, F.ldsg, S);
    for (;;) {
        const bool last = L + stride >= nitems;
        const att::BlockRef nxt = last ? cur : decode_cross(F, L + stride);
        att::block<false, false>(cur, nxt, 256, PT, F.ldsg, S);
        if (last) break;
        cur = nxt; L += stride;
    }
}

__device__ __forceinline__ void p5_diff_combine(Frame& F) {
    const int gw = F.vcu * NWAVES + F.wave, NGW = F.G * NWAVES, lane = F.lane;
    const float* dl = INP(5);
    const float s1 = wave_sum(dl[lane] * dl[128 + lane] + dl[64 + lane] * dl[192 + lane]);
    const float s2 = wave_sum(dl[256 + lane] * dl[384 + lane] + dl[320 + lane] * dl[448 + lane]);
    const float lam = expf(s1) - expf(s2) + LAMBDA_INIT;
    const f32x4 g = *(const f32x4*)(INP(6) + lane * 4);
    const bf16_t* o0 = WSP(bf16_t, WS_ODRAW); const bf16_t* o1 = o0 + (size_t)M * 2048; bf16_t* od = WSP(bf16_t, WS_OD);
    for (int it = gw; it < M * 8; it += NGW) {
        const size_t off = (size_t)it * 256 + lane * 4;
        const u32x2 a = *(const u32x2*)(o0 + off), b = *(const u32x2*)(o1 + off);
        float v[4] = {bf_lo(a.x) - lam * bf_lo(b.x), bf_hi(a.x) - lam * bf_hi(b.x), bf_lo(a.y) - lam * bf_lo(b.y), bf_hi(a.y) - lam * bf_hi(b.y)};
        const float ss = wave_sum(v[0] * v[0] + v[1] * v[1] + v[2] * v[2] + v[3] * v[3]);
        const float rs = (1.0f / sqrtf(ss * (1.0f / 256.0f) + LN_EPS)) * (1.0f - LAMBDA_INIT);
        u32x2 w; w.x = cvt_pk_bf16(v[0] * rs * g[0], v[1] * rs * g[1]); w.y = cvt_pk_bf16(v[2] * rs * g[2], v[3] * rs * g[3]);
        *(u32x2*)(od + off) = w;
    }
}

__device__ __forceinline__ void ln_phase(Frame& F, float* H, const float* g, const float* bta, bf16_t* HB) {
    const int gw = F.vcu * NWAVES + F.wave, NGW = F.G * NWAVES, lane = F.lane;
    for (int m = gw; m < M; m += NGW) {
        f32x4* xr = (f32x4*)(H + (size_t)m * DM) + lane;
        f32x4 v[8]; float s = 0.f;
#pragma unroll
        for (int j = 0; j < 8; ++j) { v[j] = xr[64 * j]; s += (v[j].x + v[j].y) + (v[j].z + v[j].w); }
        const float mean = wave_sum(s) * (1.f / DM); float s2 = 0.f;
#pragma unroll
        for (int j = 0; j < 8; ++j) { v[j] = v[j] - mean; s2 += (v[j].x * v[j].x + v[j].y * v[j].y) + (v[j].z * v[j].z + v[j].w * v[j].w); }
        const float rstd = 1.f / sqrtf(wave_sum(s2) * (1.f / DM) + LN_EPS);
#pragma unroll
        for (int j = 0; j < 8; ++j) { const f32x4 gg = *((const f32x4*)g + lane + 64 * j), bb = *((const f32x4*)bta + lane + 64 * j);
            const f32x4 o = v[j] * rstd * gg + bb; xr[64 * j] = o;
            if (HB) { u32x2 w; w.x = cvt_pk_bf16(o.x, o.y); w.y = cvt_pk_bf16(o.z, o.w); *((u32x2*)(HB + (size_t)m * DM) + lane + 64 * j) = w; } }
    }
}

__device__ __forceinline__ void p13_router(Frame& F) {
    const int lane = F.lane, wave = F.wave, c = lane & 31, hi = lane >> 5, tid = F.tid;
    const float* H = F.out; const float* rw = INP(22); const float* rbias = INP(23);
    LAS float* red = (LAS float*)(F.lds + RING_OFF);
    LAS float* lg = red + 8 * 32 * 64; LAS float* sc = lg + 32 * 65; LAS int* lcnt = (LAS int*)(sc + 32 * 65); LAS int* lbase = lcnt + 64;
    int* idxo = WSP(int, WS_IDX); int* sloto = idxo + M * 8; float* gateo = (float*)(sloto + M * 8); int* tokl = WSP(int, WS_TOKL);
    unsigned* cnt = F.ctl + CW_CNT;
    for (int unit = blockIdx.x; unit < M / 32; unit += F.G) {
        const int t0 = unit * 32;
        f32x16 a0 = {}, a1 = {};
        const float* hp = H + (size_t)(t0 + c) * DM + wave * 256 + 4 * hi;
        const float* wp = rw + (size_t)(wave * 256 + 4 * hi) * 64 + c;
#pragma unroll 2
        for (int gI = 0; gI < 32; ++gI) {
            const f32x4 av = *(const f32x4*)(hp + gI * 8);
#pragma unroll
            for (int j = 0; j < 4; ++j) { const float b0 = wp[(size_t)(gI * 8 + j) * 64], b1 = wp[(size_t)(gI * 8 + j) * 64 + 32];
                a0 = __builtin_amdgcn_mfma_f32_32x32x2f32(av[j], b0, a0, 0, 0, 0);
                a1 = __builtin_amdgcn_mfma_f32_32x32x2f32(av[j], b1, a1, 0, 0, 0); }
        }
        if (tid < 64) lcnt[tid] = 0;
#pragma unroll
        for (int r = 0; r < 16; ++r) { const int tok = (r & 3) + 8 * (r >> 2) + 4 * hi; red[(wave * 32 + tok) * 64 + c] = a0[r]; red[(wave * 32 + tok) * 64 + 32 + c] = a1[r]; }
        __syncthreads();
        for (int p = tid; p < 32 * 64; p += 512) { float s = 0.f;
#pragma unroll
            for (int w = 0; w < 8; ++w) s += red[w * 2048 + p];
            lg[(p >> 6) * 65 + (p & 63)] = s; }
        __syncthreads();
        int myidx[8]; float mygate[8]; int myslot[8];
        if (tid < 32) {
            LAS float* L = lg + tid * 65; LAS float* Sc = sc + tid * 65;
#pragma unroll 1
            for (int e = 0; e < 64; ++e) { const float s = sigmoidf_(L[e]); Sc[e] = s; L[e] = s + rbias[e]; }
            float gs[8];
#pragma unroll
            for (int gq = 0; gq < 8; ++gq) { float m1 = -__builtin_inff(), m2 = -__builtin_inff();
#pragma unroll 1
                for (int j = 0; j < 8; ++j) { const float v = L[gq * 8 + j]; if (v > m1) { m2 = m1; m1 = v; } else if (v > m2) m2 = v; }
                gs[gq] = m1 + m2; }
            unsigned gmask = 0u;
#pragma unroll
            for (int it = 0; it < 4; ++it) { float best = -__builtin_inff(); int bi = 0;
#pragma unroll
                for (int gq = 0; gq < 8; ++gq) { const bool free_ = !((gmask >> gq) & 1u); if (free_ && gs[gq] > best) { best = gs[gq]; bi = gq; } }
                gmask |= 1u << bi; }
            unsigned long long picked = 0ull; float gsum = 0.f;
#pragma unroll
            for (int it = 0; it < 8; ++it) { float best = -__builtin_inff(); int bi = 0;
#pragma unroll 1
                for (int e = 0; e < 64; ++e) { const bool ok = ((gmask >> (e >> 3)) & 1u) && !((picked >> e) & 1ull); const float v = L[e]; if (ok && v > best) { best = v; bi = e; } }
                picked |= 1ull << bi; myidx[it] = bi; mygate[it] = Sc[bi]; gsum += Sc[bi]; }
#pragma unroll
            for (int it = 0; it < 8; ++it) { mygate[it] = mygate[it] / gsum * 2.5f; myslot[it] = __hip_atomic_fetch_add(lcnt + myidx[it], 1, __ATOMIC_RELAXED, __HIP_MEMORY_SCOPE_WORKGROUP); }
        }
        __syncthreads();
        if (tid < 64) lbase[tid] = (int)__hip_atomic_fetch_add(cnt + 64 * tid, (unsigned)lcnt[tid], RLX_AGENT);
        __syncthreads();
        if (tid < 32) { const int t = t0 + tid;
#pragma unroll
            for (int it = 0; it < 8; ++it) { const int e = myidx[it], sl = lbase[e] + myslot[it];
                idxo[t * 8 + it] = e; sloto[t * 8 + it] = sl; gateo[t * 8 + it] = mygate[it]; tokl[e * 8192 + sl] = t; } }
        __syncthreads();
    }
}

struct MoeTab { LAS int* tb; LAS int* cn; };
__device__ __forceinline__ void moe_build_tab(Frame& F, const MoeTab& mt) {
    if (F.tid == 0) { int acc = 0;
        for (int e = 0; e < NE; ++e) { const int cnum = (int)__hip_atomic_load(F.ctl + CW_CNT + 64 * e, RLX_AGENT); mt.cn[e] = cnum; mt.tb[e] = acc; acc += (cnum + 255) >> 8; }
        mt.cn[NE] = M; mt.tb[NE] = acc; acc += M / 256; mt.tb[NEX] = acc; }
    __syncthreads();
}
template <bool GATHER>
struct MoeOrder {
    LAS const int* tb; LAS const int* cn; const int* tokl; int nN, G, c, total;
    __device__ __forceinline__ bool next(int i, pg8::Unit& u) const {
        const long L = (long)i * G + c; if (L >= total) return false;
        u.pm = (int)L / nN; u.pn = (int)L % nN;
        int lo = 0, hi = NEX;
        while (hi - lo > 1) { const int mid = (lo + hi) >> 1; if (tb[mid] <= u.pm) lo = mid; else hi = mid; }
        u.e = lo; return true;
    }
    __device__ __forceinline__ int tok(const pg8::Unit& u, int r) const {
        if (!GATHER) return u.pm * 256 + r;
        const int ri = (u.pm - tb[u.e]) * 256 + r;
        if (u.e == NE) return ri;
        return ri < cn[u.e] ? tokl[u.e * 8192 + ri] : 0;
    }
};

__device__ __forceinline__ void p17_combine(Frame& F, const MoeTab& mt) {
    const int gw = F.vcu * NWAVES + F.wave, NGW = F.G * NWAVES, lane = F.lane;
    const int* idxo = WSP(int, WS_IDX); const int* sloto = idxo + M * 8; const float* gateo = (const float*)(sloto + M * 8);
    const bf16_t* outr = WSP(bf16_t, WS_OUTROWS); const float* g = INP(30); const float* bta = INP(31);
    for (int t = gw; t < M; t += NGW) {
        f32x4* xr = (f32x4*)(F.out + (size_t)t * DM);
        f32x4 v[8];
#pragma unroll
        for (int j = 0; j < 4; ++j) { v[2 * j] = xr[128 * j + 2 * lane] * DN_ALPHA; v[2 * j + 1] = xr[128 * j + 2 * lane + 1] * DN_ALPHA; }
        for (int k = 0; k < 9; ++k) {
            int row; float gt;
            if (k < 8) { const int e = idxo[t * 8 + k]; row = mt.tb[e] * 256 + sloto[t * 8 + k]; gt = gateo[t * 8 + k]; }
            else { row = mt.tb[NE] * 256 + t; gt = 1.0f; }
            const u32x4* rp = (const u32x4*)(outr + (size_t)row * DM);
#pragma unroll
            for (int j = 0; j < 4; ++j) { const u32x4 w = rp[64 * j + lane];
                v[2 * j] += (f32x4){bf_lo(w.x), bf_hi(w.x), bf_lo(w.y), bf_hi(w.y)} * gt; v[2 * j + 1] += (f32x4){bf_lo(w.z), bf_hi(w.z), bf_lo(w.w), bf_hi(w.w)} * gt; }
        }
        float s = 0.f;
#pragma unroll
        for (int j = 0; j < 8; ++j) s += (v[j].x + v[j].y) + (v[j].z + v[j].w);
        const float mean = wave_sum(s) * (1.f / DM); float s2 = 0.f;
#pragma unroll
        for (int j = 0; j < 8; ++j) { v[j] = v[j] - mean; s2 += (v[j].x * v[j].x + v[j].y * v[j].y) + (v[j].z * v[j].z + v[j].w * v[j].w); }
        const float rstd = 1.f / sqrtf(wave_sum(s2) * (1.f / DM) + LN_EPS);
#pragma unroll
        for (int j = 0; j < 4; ++j) {
#pragma unroll
            for (int q = 0; q < 2; ++q) { const int ci = 128 * j + 2 * lane + q; const f32x4 gg = *((const f32x4*)g + ci), bb = *((const f32x4*)bta + ci);
                xr[ci] = v[2 * j + q] * rstd * gg + bb; } }
    }
}
#ifndef MK_PER_PHASE
#define MK_PER_PHASE 0
#endif
constexpr int NPHASES = 18;
__global__ void __launch_bounds__(NWAVES * 64, 2) hybrid_fwd(Args args) {
    extern __shared__ __attribute__((aligned(16))) unsigned char lds[];
    Frame F;
    F.lds = (LAS unsigned char*)lds; F.ldsg = (char*)lds;
    F.tid = threadIdx.x; F.lane = F.tid & 63; F.wave = __builtin_amdgcn_readfirstlane(F.tid >> 6);
    F.G = gridDim.x; { const int bx = blockIdx.x; F.vcu = (F.G % 8 == 0) ? (bx % 8) * (F.G / 8) + bx / 8 : bx; }
    F.ka = (const __attribute__((address_space(4))) char*)__builtin_amdgcn_kernarg_segment_ptr(); F.out = args.out; F.ws = args.ws; F.ctl = (unsigned*)(args.ws + WS_CTL);
    volatile LAS unsigned* MISC = (volatile LAS unsigned*)(F.lds + MISC_OFF);
    for (int u = F.tid; u < (LDS_BYTES - LDSCTL_OFF) / 4; u += NWAVES * 64) ((LAS unsigned*)(F.lds + LDSCTL_OFF))[u] = 0u;
    __syncthreads();
    XcdBarrier bar; bar.bar = F.ctl + CW_BAR; bar.x = 0; bar.st = nullptr;
    const int lo = args.ph_lo, hi = args.ph_hi;
    if (hi - lo > 1) bar = xcd_barrier_post(F.ctl + CW_BAR, MISC + 8);
#ifndef PHASE_MASK
#define PHASE_MASK 0xFFFFFFFFu
#endif
#define IN(k) (lo <= (k) && (k) < hi && ((PHASE_MASK >> (k)) & 1u))
#define PHASE_BEGIN() asm volatile("" : "+s"(F.ka))
#define SEAM(k) do { if (IN(k) && IN((k) + 1)) xcd_barrier(bar); } while (0)
    const MoeTab mt{(LAS int*)(F.lds + LDSCTL_OFF + 512), (LAS int*)(F.lds + LDSCTL_OFF + 512 + 272)};

    if (IN(0)) { PHASE_BEGIN(); p0_prologue(F); } SEAM(0);
    if (IN(1)) { PHASE_BEGIN(); pg8::Gemm g{WSP(bf16_t, WS_XB), WSP(bf16_t, WS_WINT), 2048, 0}; pg8::DenseOrder S; S.init(M, LDP, F.G, (int)blockIdx.x);
        pg8::EpiProj E{WSP(bf16_t, WS_PROJ), LDP, WSP(float, WS_SIDE)};
        pg8::gemm_phase<pg8::EpiProj, pg8::DenseOrder, true>(F.lds + RING_OFF, g, S, E); } SEAM(1);
    if (IN(2)) { PHASE_BEGIN(); p2_token_norms(F); } SEAM(2);
    if (IN(3)) { PHASE_BEGIN(); { pg8::Gemm g{WSP(bf16_t, WS_CB), WSP(bf16_t, WS_WKVS), 512, 0}; pg8::DenseOrder S; S.init(M, 2048, F.G, (int)blockIdx.x);
        pg8::EpiBf16 E{WSP(bf16_t, WS_KVS), 2048};
        pg8::gemm_phase<pg8::EpiBf16, pg8::DenseOrder, true>(F.lds + RING_OFF, g, S, E); }
        p3_indexer(F); } SEAM(3);
    if (IN(4)) { PHASE_BEGIN();
#if !defined(ATT_ONLY) || ATT_ONLY == 1
        attn_self_phase<false>(F, 0, 128); __syncthreads();
#endif
#if !defined(ATT_ONLY) || ATT_ONLY == 2
        attn_self_phase<true>(F, 128, 160);
#endif
    } SEAM(4);
    if (IN(5)) { PHASE_BEGIN(); p5_diff_combine(F); } SEAM(5);
    if (IN(6)) { PHASE_BEGIN(); pg8::Gemm g{WSP(bf16_t, WS_OD), WSP(bf16_t, WS_WPD), 2048, 0}; pg8::DenseOrder S; S.init(M, 2048, F.G, (int)blockIdx.x);
        pg8::EpiGateA E{WSP(bf16_t, WS_MERGED), 2048, WSP(bf16_t, WS_PROJ) + C_GD, LDP};
        pg8::gemm_phase<pg8::EpiGateA, pg8::DenseOrder, true>(F.lds + RING_OFF, g, S, E); } SEAM(6);
    if (IN(7)) { PHASE_BEGIN(); pg8::Gemm g{WSP(bf16_t, WS_OS), WSP(bf16_t, WS_WPS), 1024, 0}; pg8::DenseOrder S; S.init(M, 2048, F.G, (int)blockIdx.x);
        pg8::EpiGateB E{WSP(bf16_t, WS_MERGED), 2048, WSP(bf16_t, WS_PROJ) + C_GS, LDP};
        pg8::gemm_phase<pg8::EpiGateB, pg8::DenseOrder, true>(F.lds + RING_OFF, g, S, E); } SEAM(7);
    if (IN(8)) { PHASE_BEGIN(); pg8::Gemm g{WSP(bf16_t, WS_MERGED), WSP(bf16_t, WS_WMO), 2048, 0}; pg8::DenseOrder S; S.init(M, 2048, F.G, (int)blockIdx.x);
        pg8::EpiResid E{F.out, INP(0), 2048, DN_ALPHA};
        pg8::gemm_phase<pg8::EpiResid, pg8::DenseOrder, true>(F.lds + RING_OFF, g, S, E); } SEAM(8);
    if (IN(9)) { PHASE_BEGIN(); ln_phase(F, F.out, INP(15), INP(16), WSP(bf16_t, WS_HB)); } SEAM(9);
    if (IN(10)) { PHASE_BEGIN(); { pg8::Gemm g{WSP(bf16_t, WS_HB), WSP(bf16_t, WS_WXQ), 2048, 0}; pg8::DenseOrder S; S.init(M, 512, F.G, (int)blockIdx.x);
        pg8::EpiBf16 E{WSP(bf16_t, WS_XQ), 512};
        pg8::gemm_phase<pg8::EpiBf16, pg8::DenseOrder, true>(F.lds + RING_OFF, g, S, E); }
        { pg8::Gemm g{WSP(bf16_t, WS_MEMB), WSP(bf16_t, WS_WXKV), 2048, 0}; pg8::DenseOrder S; S.init(1024, 1024, F.G, (int)blockIdx.x - 64);
        pg8::EpiBf16 E{WSP(bf16_t, WS_XKV), 1024};
        pg8::gemm_phase<pg8::EpiBf16, pg8::DenseOrder, true>(F.lds + RING_OFF, g, S, E); } } SEAM(10);
    if (IN(11)) { PHASE_BEGIN(); attn_cross_phase(F); } SEAM(11);
    if (IN(12)) { PHASE_BEGIN(); pg8::Gemm g{WSP(bf16_t, WS_XO), WSP(bf16_t, WS_WXO), 512, 0}; pg8::DenseOrder S; S.init(M, 2048, F.G, (int)blockIdx.x);
        pg8::EpiResid E{F.out, F.out, 2048, DN_ALPHA};
        pg8::gemm_phase<pg8::EpiResid, pg8::DenseOrder, true>(F.lds + RING_OFF, g, S, E); } SEAM(12);
    if (IN(13)) { PHASE_BEGIN(); ln_phase(F, F.out, INP(20), INP(21), WSP(bf16_t, WS_HB)); } SEAM(13);
    if (IN(14)) { PHASE_BEGIN(); p13_router(F); } SEAM(14);
    if (IN(15)) { PHASE_BEGIN(); moe_build_tab(F, mt);
        pg8::Gemm g{WSP(bf16_t, WS_HB), WSP(bf16_t, WS_W13T), 2048, (size_t)1024 * 2048 * 2};
        MoeOrder<true> S{mt.tb, mt.cn, WSP(int, WS_TOKL), 4, F.G, (int)blockIdx.x, mt.tb[NEX] * 4};
        pg8::EpiSilu E{WSP(bf16_t, WS_ACT), 512};
        pg8::gemm_phase<pg8::EpiSilu, MoeOrder<true>, true>(F.lds + RING_OFF, g, S, E); } SEAM(15);
    if (IN(16)) { PHASE_BEGIN(); moe_build_tab(F, mt);
        pg8::Gemm g{WSP(bf16_t, WS_ACT), WSP(bf16_t, WS_W2T), 512, (size_t)2048 * 512 * 2};
        MoeOrder<false> S{mt.tb, mt.cn, WSP(int, WS_TOKL), 8, F.G, (int)blockIdx.x, mt.tb[NEX] * 8};
        pg8::EpiBf16 E{WSP(bf16_t, WS_OUTROWS), 2048};
        pg8::gemm_phase<pg8::EpiBf16, MoeOrder<false>, true>(F.lds + RING_OFF, g, S, E); } SEAM(16);
    if (IN(17)) { PHASE_BEGIN(); moe_build_tab(F, mt); p17_combine(F, mt); }
#undef IN
#undef SEAM
}

extern "C" void kernel_launch(void* const* d_in, const int* in_sizes, int n_in, void* d_out, int out_size, void* d_ws, size_t ws_size, hipStream_t stream) {
    static int grid = 0;
    if (grid == 0) {
        if (n_in != 32 || out_size != M * DM || ws_size < WS_END) { fprintf(stderr, "kernel_launch: unexpected shapes (n_in %d, out %d, ws %zu); nothing launched\n", n_in, out_size, ws_size); grid = -1; return; }
        int dev = 0, cus = 0, per_cu = 0;
        if (hipGetDevice(&dev) != hipSuccess || hipDeviceGetAttribute(&cus, hipDeviceAttributeMultiprocessorCount, dev) != hipSuccess) { grid = -1; return; }
        if (hipFuncSetAttribute((const void*)hybrid_fwd, hipFuncAttributeMaxDynamicSharedMemorySize, LDS_BYTES) != hipSuccess) { fprintf(stderr, "kernel_launch: hipFuncSetAttribute failed\n"); grid = -1; return; }
        if (hipOccupancyMaxActiveBlocksPerMultiprocessor(&per_cu, (const void*)hybrid_fwd, NWAVES * 64, LDS_BYTES) != hipSuccess || per_cu < 1) { fprintf(stderr, "kernel_launch: occupancy query says %d\n", per_cu); }
        (void)hipGetLastError();
        grid = cus;
    }
    if (grid < 0) return;
    (void)hipMemsetAsync((char*)d_ws + WS_CTL, 0, CTL_ZERO_BYTES, stream);
    Args a{};
    for (int i = 0; i < 32; ++i) a.in[i] = (const float*)d_in[i];
    a.out = (float*)d_out; a.ws = (unsigned char*)d_ws;
#if MK_PER_PHASE
    for (int p = 0; p < NPHASES; ++p) { a.ph_lo = p; a.ph_hi = p + 1; hipLaunchKernelGGL(hybrid_fwd, dim3(grid), dim3(NWAVES * 64), LDS_BYTES, stream, a); }
#else
    a.ph_lo = 0; a.ph_hi = NPHASES;
    hipLaunchKernelGGL(hybrid_fwd, dim3(grid), dim3(NWAVES * 64), LDS_BYTES, stream, a);
#endif
}
```

```cpp
#include <hip/hip_runtime.h>
#include <cstdio>
#include <cstdint>

#define LAS __attribute__((address_space(3)))
#define GAS __attribute__((address_space(1)))
typedef unsigned short bf16_t;
typedef short bf16x8 __attribute__((ext_vector_type(8)));
typedef short s16x4 __attribute__((ext_vector_type(4)));
typedef float f32x4 __attribute__((ext_vector_type(4)));
typedef float f32x2 __attribute__((ext_vector_type(2)));
typedef float f32x16 __attribute__((ext_vector_type(16)));
typedef unsigned u32x4 __attribute__((ext_vector_type(4)));
typedef unsigned u32x2 __attribute__((ext_vector_type(2)));

__device__ __forceinline__ unsigned cvt_pk_bf16(float lo, float hi) { unsigned r; asm volatile("v_cvt_pk_bf16_f32 %0, %1, %2" : "=v"(r) : "v"(lo), "v"(hi)); return r; }
__device__ __forceinline__ float bf_lo(unsigned w) { return __builtin_bit_cast(float, w << 16); }
__device__ __forceinline__ float bf_hi(unsigned w) { return __builtin_bit_cast(float, w & 0xffff0000u); }
__device__ __forceinline__ float sigmoidf_(float v) { return 1.0f / (1.0f + __expf(-v)); }
__device__ __forceinline__ float wave_sum(float v) {
#pragma unroll
    for (int o = 1; o < 64; o <<= 1) v += __shfl_xor(v, o);
    return v;
}

__device__ __forceinline__ int fresh_lane() { int l = (int)__builtin_amdgcn_mbcnt_hi(~0u, __builtin_amdgcn_mbcnt_lo(~0u, 0u)); asm volatile("" : "+v"(l)); return l; }

namespace pg8 {
constexpr int BM = 256, BK = 64, HALF = 128, HTB = HALF * BK * 2, STAGE_BYTES = 8 * HTB;
__host__ __device__ __forceinline__ int lds_byte(int r, int c) { const int st = (r >> 4) * 2 + (c >> 5), rr = r & 15, cc = c & 31, ob = rr * 64 + cc * 2; return st * 1024 + (ob ^ (((ob >> 9) & 1) << 5)); }
__host__ __device__ __forceinline__ void stage_rc(int b, int& R, int& C) { const int st = b / 1024, sb = b % 1024, swz = sb ^ (((sb >> 9) & 1) << 5); R = (st >> 1) * 16 + swz / 64; C = (st & 1) * 32 + (swz % 64) / 2; }
__host__ __device__ __forceinline__ int perm32(int rho) { const int n = rho >> 4, i = rho & 15; return 8 * (i >> 2) + 4 * n + (i & 3); }

struct Unit { int pm, pn, e; };
struct Gemm { const bf16_t* A; const bf16_t* Bt; int K; size_t bexp; };

struct DenseOrder {
    int nM, nN, nwg, G, c;
    __device__ void init(int M, int N, int G_, int c_) { nM = M / BM; nN = N / BM; nwg = nM * nN; G = G_; c = c_; }
    __device__ __forceinline__ bool next(int i, Unit& u) const {
        if (c < 0) return false;
        const long L = (long)i * G + c; if (L >= nwg) return false;
        int wgid = (int)L; { const int q = nwg / 8, r = nwg % 8, xcd = wgid % 8, off = wgid / 8; wgid = (xcd < r ? xcd * (q + 1) : r * (q + 1) + (xcd - r) * q) + off; }
        const int nig = 8 * nN, gid = wgid / nig, fm = gid * 8, gsz = (nM - fm) < 8 ? (nM - fm) : 8;
        u.pm = fm + ((wgid % nig) % gsz); u.pn = (wgid % nig) / gsz; u.e = 0; return true;
    }
    __device__ __forceinline__ int tok(const Unit& u, int r) const { return u.pm * BM + r; }
};

template <class Epi, class Sched, bool ALIGN_EPI>
__device__ __forceinline__ void gemm_phase(LAS unsigned char* lds, const Gemm g, const Sched& S, const Epi& E, const int wid) {
    const int lane = fresh_lane(), tid = wid * 64 + lane, wr = wid >> 2, wc = wid & 3, fr = lane & 15, fq = lane >> 4;
    const int K = g.K, nt = K / BK;
    int Rr[2], Cc[2]; unsigned voffB[2];
#pragma unroll
    for (int i = 0; i < 2; ++i) { int R, C; stage_rc(tid * 16 + i * 8192, R, C); const int Rb = (R & ~31) + perm32(R & 31); Rr[i] = R; Cc[i] = C; voffB[i] = (unsigned)(Rb * K + C) * 2u; }
    const size_t kstep = (size_t)(BK * 2);
    const size_t hstep = (size_t)HALF * K * 2;
    const size_t tstep = 2 * hstep;
    const unsigned ldsw = (unsigned)wid * 1024u;
    const int aoff = lds_byte(wr * 64 + fr, fq * 8), boff = lds_byte(wc * 32 + fr, fq * 8);
#define PG8_SA(b, h) (((b) * 2 + (h)) * HTB)
#define PG8_SB(b, h) ((4 + (b) * 2 + (h)) * HTB)
#define PG8_STAGE(bufoff, gbase, voff) do { _Pragma("unroll") for (int _i = 0; _i < 2; ++_i) \
        __builtin_amdgcn_global_load_lds((const unsigned*)((const char*)(gbase) + (voff)[_i]), (LAS unsigned*)(lds + (bufoff) + ldsw + _i * 8192), 16, 0, 0); } while (0)
#define PG8_LDA(dst, b, h) do { _Pragma("unroll") for (int m = 0; m < 4; ++m) _Pragma("unroll") for (int k = 0; k < 2; ++k) dst[m][k] = *(const LAS bf16x8*)(lds + PG8_SA(b, h) + aoff + m * 2048 + k * 1024); } while (0)
#define PG8_LDB(dst, b, h) do { _Pragma("unroll") for (int n = 0; n < 2; ++n) _Pragma("unroll") for (int k = 0; k < 2; ++k) dst[n][k] = *(const LAS bf16x8*)(lds + PG8_SB(b, h) + boff + n * 2048 + k * 1024); } while (0)
#define PG8_MMA(ai, bj, At, Bt) do { __builtin_amdgcn_s_setprio(1); _Pragma("unroll") for (int m = 0; m < 4; ++m) _Pragma("unroll") for (int n = 0; n < 2; ++n) _Pragma("unroll") for (int k = 0; k < 2; ++k) \
        acc[ai][bj][m][n] = __builtin_amdgcn_mfma_f32_16x16x32_bf16(Bt[n][k], At[m][k], acc[ai][bj][m][n], 0, 0, 0); __builtin_amdgcn_s_setprio(0); } while (0)
#define PG8_WAIT_V(n) asm volatile("s_waitcnt vmcnt(" #n ")" ::: "memory")
#define PG8_WAIT_L(n) asm volatile("s_waitcnt lgkmcnt(" #n ")" ::: "memory")
#define PG8_BAR __builtin_amdgcn_s_barrier()
#define PG8_SCHED __builtin_amdgcn_sched_barrier(0)
#define PG8_SETVO(vo, u) do { _Pragma("unroll") for (int _h = 0; _h < 2; ++_h) _Pragma("unroll") for (int _i = 0; _i < 2; ++_i) \
        vo[_h][_i] = (unsigned)(S.tok(u, _h * HALF + Rr[_i]) * K + Cc[_i]) * 2u; } while (0)
    Unit cur, nxt; int ui = 0;
    if (!S.next(0, cur)) return;
    f32x4 acc[2][2][4][2];
#pragma unroll
    for (int a = 0; a < 2; ++a)
#pragma unroll
        for (int b = 0; b < 2; ++b)
#pragma unroll
            for (int m = 0; m < 4; ++m)
#pragma unroll
                for (int n = 0; n < 2; ++n) acc[a][b][m][n] = (f32x4){0.f, 0.f, 0.f, 0.f};
    bf16x8 At[4][2], B0[2][2], B1[2][2];
    unsigned voC[2][2], voN[2][2];
    PG8_SETVO(voC, cur);
    const char* const cA = (const char*)g.A;
    const char* cB = (const char*)g.Bt + (size_t)cur.e * g.bexp + (size_t)cur.pn * tstep;
    PG8_STAGE(PG8_SB(0, 0), cB, voffB); PG8_STAGE(PG8_SB(0, 1), cB + hstep, voffB); PG8_STAGE(PG8_SA(0, 0), cA, voC[0]); PG8_STAGE(PG8_SA(0, 1), cA, voC[1]);
    if (wr == 1) PG8_BAR;
    PG8_WAIT_V(2); PG8_BAR;
    PG8_STAGE(PG8_SB(1, 0), cB + kstep, voffB); PG8_STAGE(PG8_SA(1, 0), cA + kstep, voC[0]); PG8_STAGE(PG8_SB(1, 1), cB + hstep + kstep, voffB);
    PG8_WAIT_V(6); PG8_BAR;
    for (;;) {
        const bool has_next = S.next(ui + 1, nxt);
        if (has_next) { PG8_SETVO(voN, nxt); }
        else {
#pragma unroll
            for (int h = 0; h < 2; ++h) { voN[h][0] = voC[h][0]; voN[h][1] = voC[h][1]; } }
        const char* nB = has_next ? (const char*)g.Bt + (size_t)nxt.e * g.bexp + (size_t)nxt.pn * tstep : cB;
        for (int t = 0; t < nt; t += 2) {
            const bool last = (t == nt - 2);
            const char* a1 = cA + (size_t)(t + 1) * kstep;
            const char* a2 = last ? cA : cA + (size_t)(t + 2) * kstep; const char* b2 = last ? nB : cB + (size_t)(t + 2) * kstep;
            const char* a3 = a2 + kstep; const char* b3 = b2 + kstep;
            unsigned vo2[2][2];
#pragma unroll
            for (int h = 0; h < 2; ++h) { vo2[h][0] = last ? voN[h][0] : voC[h][0]; vo2[h][1] = last ? voN[h][1] : voC[h][1]; }
            PG8_LDB(B0, 0, 0); PG8_LDB(B1, 0, 1); PG8_SCHED; PG8_LDA(At, 0, 0); PG8_STAGE(PG8_SA(1, 1), a1, voC[1]);
            PG8_WAIT_V(8); PG8_WAIT_L(0); PG8_BAR; PG8_MMA(0, 0, At, B0); PG8_MMA(0, 1, At, B1); PG8_BAR; PG8_SCHED;
            PG8_LDA(At, 0, 1); PG8_STAGE(PG8_SB(0, 0), b2, voffB); PG8_STAGE(PG8_SB(0, 1), b2 + hstep, voffB); PG8_STAGE(PG8_SA(0, 0), a2, vo2[0]);
            PG8_WAIT_V(8); PG8_WAIT_L(0); PG8_BAR; PG8_MMA(1, 0, At, B0); PG8_MMA(1, 1, At, B1); PG8_BAR; PG8_SCHED;
            PG8_LDB(B0, 1, 0); PG8_LDB(B1, 1, 1); PG8_SCHED; PG8_LDA(At, 1, 0); PG8_STAGE(PG8_SA(0, 1), a2, vo2[1]);
            PG8_WAIT_V(8); PG8_WAIT_L(0); PG8_BAR; PG8_MMA(0, 0, At, B0); PG8_MMA(0, 1, At, B1); PG8_BAR; PG8_SCHED;
            PG8_LDA(At, 1, 1); PG8_STAGE(PG8_SB(1, 0), b3, voffB); PG8_STAGE(PG8_SB(1, 1), b3 + hstep, voffB); PG8_STAGE(PG8_SA(1, 0), a3, vo2[0]);
            PG8_WAIT_V(8); PG8_WAIT_L(0); PG8_BAR; PG8_MMA(1, 0, At, B0); PG8_MMA(1, 1, At, B1); PG8_BAR; PG8_SCHED;
        }
        if constexpr (ALIGN_EPI) { if (wr == 0) PG8_BAR; }
        E(acc, cur, wr, wc, fr, fq);
        if (!has_next) break;
#pragma unroll
        for (int a = 0; a < 2; ++a)
#pragma unroll
            for (int b = 0; b < 2; ++b)
#pragma unroll
                for (int m = 0; m < 4; ++m)
#pragma unroll
                    for (int n = 0; n < 2; ++n) acc[a][b][m][n] = (f32x4){0.f, 0.f, 0.f, 0.f};
        cur = nxt; cB = nB; ++ui;
#pragma unroll
        for (int h = 0; h < 2; ++h) { voC[h][0] = voN[h][0]; voC[h][1] = voN[h][1]; }
        if constexpr (ALIGN_EPI) { if (wr == 1) PG8_BAR; }
    }
    PG8_WAIT_V(0);
    if constexpr (!ALIGN_EPI) { if (wr == 0) PG8_BAR; }
    PG8_BAR;
#undef PG8_SA
#undef PG8_SB
#undef PG8_STAGE
#undef PG8_LDA
#undef PG8_LDB
#undef PG8_MMA
#undef PG8_WAIT_V
#undef PG8_WAIT_L
#undef PG8_BAR
#undef PG8_SCHED
#undef PG8_SETVO
}

#define EPI_ROWS_BEGIN const int row0 = u.pm * BM + wr * 64 + fr; const int colw = wc * 32 + 8 * fq; \
    _Pragma("unroll") for (int ai = 0; ai < 2; ++ai) _Pragma("unroll") for (int m = 0; m < 4; ++m) { const size_t row = (size_t)(row0 + ai * HALF + m * 16);
#define EPI_ROWS_END }
__device__ __forceinline__ u32x4 pack8(f32x4 v0, f32x4 v1) { u32x4 w; w.x = cvt_pk_bf16(v0[0], v0[1]); w.y = cvt_pk_bf16(v0[2], v0[3]); w.z = cvt_pk_bf16(v1[0], v1[1]); w.w = cvt_pk_bf16(v1[2], v1[3]); return w; }

struct EpiBf16 {
    bf16_t* O; int ldc;
    __device__ __forceinline__ void operator()(const f32x4 (&acc)[2][2][4][2], const Unit& u, int wr, int wc, int fr, int fq) const {
        EPI_ROWS_BEGIN
            bf16_t* rowp = O + row * ldc + u.pn * BM + colw;
#pragma unroll
            for (int bj = 0; bj < 2; ++bj) *(u32x4*)(rowp + bj * HALF) = pack8(acc[ai][bj][m][0], acc[ai][bj][m][1]);
        EPI_ROWS_END
    }
};
struct EpiProj {
    bf16_t* O; int ldc; float* side;
    __device__ __forceinline__ void operator()(const f32x4 (&acc)[2][2][4][2], const Unit& u, int wr, int wc, int fr, int fq) const {
        const bool sd = (u.pn == 34) && (wc * 32 + 8 * fq < 80);
        EPI_ROWS_BEGIN
            bf16_t* rowp = O + row * ldc + u.pn * BM + colw;
#pragma unroll
            for (int bj = 0; bj < 2; ++bj) *(u32x4*)(rowp + bj * HALF) = pack8(acc[ai][bj][m][0], acc[ai][bj][m][1]);
            if (sd) { float* sp = side + row * 80 + colw; *(f32x4*)sp = acc[ai][0][m][0]; *(f32x4*)(sp + 4) = acc[ai][0][m][1]; }
        EPI_ROWS_END
    }
};
struct EpiGateA {
    bf16_t* O; int ldc; const bf16_t* G; int ldg;
    __device__ __forceinline__ void operator()(const f32x4 (&acc)[2][2][4][2], const Unit& u, int wr, int wc, int fr, int fq) const {
        EPI_ROWS_BEGIN
#pragma unroll
            for (int bj = 0; bj < 2; ++bj) { const int col = u.pn * BM + colw + bj * HALF;
                const u32x4 gw = *(const u32x4*)(G + row * ldg + col);
                f32x4 v0 = acc[ai][bj][m][0], v1 = acc[ai][bj][m][1];
                v0[0] *= sigmoidf_(bf_lo(gw.x)); v0[1] *= sigmoidf_(bf_hi(gw.x)); v0[2] *= sigmoidf_(bf_lo(gw.y)); v0[3] *= sigmoidf_(bf_hi(gw.y));
                v1[0] *= sigmoidf_(bf_lo(gw.z)); v1[1] *= sigmoidf_(bf_hi(gw.z)); v1[2] *= sigmoidf_(bf_lo(gw.w)); v1[3] *= sigmoidf_(bf_hi(gw.w));
                *(u32x4*)(O + row * ldc + col) = pack8(v0, v1); }
        EPI_ROWS_END
    }
};
struct EpiGateB {
    bf16_t* O; int ldc; const bf16_t* G; int ldg;
    __device__ __forceinline__ void operator()(const f32x4 (&acc)[2][2][4][2], const Unit& u, int wr, int wc, int fr, int fq) const {
        EPI_ROWS_BEGIN
#pragma unroll
            for (int bj = 0; bj < 2; ++bj) { const int col = u.pn * BM + colw + bj * HALF;
                const u32x4 gw = *(const u32x4*)(G + row * ldg + col);
                const u32x4 ow = *(const u32x4*)(O + row * ldc + col);
                f32x4 v0 = acc[ai][bj][m][0], v1 = acc[ai][bj][m][1];
                v0[0] = bf_lo(ow.x) + v0[0] * sigmoidf_(bf_lo(gw.x)); v0[1] = bf_hi(ow.x) + v0[1] * sigmoidf_(bf_hi(gw.x));
                v0[2] = bf_lo(ow.y) + v0[2] * sigmoidf_(bf_lo(gw.y)); v0[3] = bf_hi(ow.y) + v0[3] * sigmoidf_(bf_hi(gw.y));
                v1[0] = bf_lo(ow.z) + v1[0] * sigmoidf_(bf_lo(gw.z)); v1[1] = bf_hi(ow.z) + v1[1] * sigmoidf_(bf_hi(gw.z));
                v1[2] = bf_lo(ow.w) + v1[2] * sigmoidf_(bf_lo(gw.w)); v1[3] = bf_hi(ow.w) + v1[3] * sigmoidf_(bf_hi(gw.w));
                *(u32x4*)(O + row * ldc + col) = pack8(v0, v1); }
        EPI_ROWS_END
    }
};
struct EpiResid {
    float* Z; const float* R; int ldc; float alpha;
    __device__ __forceinline__ void operator()(const f32x4 (&acc)[2][2][4][2], const Unit& u, int wr, int wc, int fr, int fq) const {
        EPI_ROWS_BEGIN
#pragma unroll
            for (int bj = 0; bj < 2; ++bj) { const size_t o = row * ldc + u.pn * BM + colw + bj * HALF;
                const f32x4 r0 = *(const f32x4*)(R + o), r1 = *(const f32x4*)(R + o + 4);
                *(f32x4*)(Z + o) = r0 * alpha + acc[ai][bj][m][0]; *(f32x4*)(Z + o + 4) = r1 * alpha + acc[ai][bj][m][1]; }
        EPI_ROWS_END
    }
};
struct EpiSilu {
    bf16_t* O; int ldc;
    __device__ __forceinline__ void operator()(const f32x4 (&acc)[2][2][4][2], const Unit& u, int wr, int wc, int fr, int fq) const {
        EPI_ROWS_BEGIN
            f32x4 v0, v1;
#pragma unroll
            for (int j = 0; j < 4; ++j) { const float a0 = acc[ai][0][m][0][j], a1 = acc[ai][0][m][1][j];
                v0[j] = a0 * sigmoidf_(a0) * acc[ai][1][m][0][j]; v1[j] = a1 * sigmoidf_(a1) * acc[ai][1][m][1][j]; }
            *(u32x4*)(O + row * ldc + u.pn * HALF + colw) = pack8(v0, v1);
        EPI_ROWS_END
    }
};
}
namespace att {
constexpr int D = 128;
constexpr float SCALE = 0.08838834764831845f;
constexpr float THR = 8.f;
constexpr int NW = 8, QBLK = 32, KVBLK = 64, QB = NW * QBLK;
constexpr int SHM_V = KVBLK * D * 2, SHM_K = KVBLK * D * 2;
constexpr int BT_OFF = 2 * SHM_V + 2 * SHM_K + NW * 64 * 4;
constexpr int BT_STRIDE = 132;
constexpr int LDS_BYTES = BT_OFF + 2 * BT_STRIDE * 4;

#define KSWZ(row, colB) ((row) * 256 + ((colB) ^ (((row) & 7) << 4)))
#define SBAR() __builtin_amdgcn_sched_barrier(0)
__device__ __forceinline__ int v_st(int k, int c) { const int kk = (k & ~0xC) | ((k & 4) << 1) | ((k & 8) >> 1); return ((kk >> 3) * 4 + (c >> 5)) * 512 + ((kk & 7) * 32 + (c & 31)) * 2; }
__device__ __forceinline__ int v_rd_base(int lane) { return ((lane & 3) << 3) | (((lane >> 2) & 3) << 6) | (((lane >> 4) & 1) << 5) | (((lane >> 5) & 1) << 8); }
constexpr int v_rd_off(int d0, int ks, int half) { return d0 * 512 + ks * 4096 + half * 2048; }
__device__ __forceinline__ int crow(int r, int hi) { return (r & 3) + 8 * (r >> 2) + 4 * hi; }
__device__ __forceinline__ bf16x8 load8(const bf16_t* p) { return *reinterpret_cast<const bf16x8*>(p); }
__device__ __forceinline__ bf16x8 load8b(const bf16_t* base, unsigned byteoff) { return *reinterpret_cast<const bf16x8*>((const char*)base + byteoff); }

__device__ __forceinline__ void mask_causal(f32x16& p0, f32x16& p1, int dq) {
    const float NEG = -__builtin_inff();
#pragma unroll
    for (int r = 0; r < 16; ++r) {
        const int c = (r & 3) + 8 * (r >> 2);
        if (dq - c < 0) p0[r] = NEG;
        if (dq - c - 32 < 0) p1[r] = NEG;
    }
}
__device__ __forceinline__ void add_bias(f32x16& p0, f32x16& p1, int dq, const float* bt) {
#pragma unroll
    for (int g = 0; g < 4; ++g) {
#pragma unroll
        for (int q = 0; q < 4; ++q) { const int r = 4 * g + q; const int c = (r & 3) + 8 * (r >> 2);
            int r0 = dq - c, r1 = dq - c - 32;
            r0 = r0 < 0 ? 0 : (r0 > 128 ? 128 : r0); r1 = r1 < 0 ? 0 : (r1 > 128 ? 128 : r1);
            p0[r] += bt[r0]; p1[r] += bt[r1]; }
        SBAR();
    }
}
__device__ __forceinline__ void mask_sel(f32x16& p0, f32x16& p1, unsigned long long w, int hi) {
    const float NEG = -__builtin_inff();
    const unsigned lo = (unsigned)w >> (4 * hi), hw = (unsigned)(w >> 32) >> (4 * hi);
#pragma unroll
    for (int r = 0; r < 16; ++r) {
        const int c = (r & 3) + 8 * (r >> 2);
        if (!((lo >> c) & 1u)) p0[r] = NEG;
        if (!((hw >> c) & 1u)) p1[r] = NEG;
    }
}
__device__ __forceinline__ void partialSM(f32x16& p0, f32x16& p1, float& m_reg, float& mn, float& alpha) {
    float pmax = p0[0]; for (int r = 1; r < 16; ++r) pmax = fmaxf(pmax, p0[r]); for (int r = 0; r < 16; ++r) pmax = fmaxf(pmax, p1[r]);
    { auto rr = __builtin_amdgcn_permlane32_swap(__float_as_uint(pmax), __float_as_uint(pmax), false, false);
      pmax = fmaxf(__uint_as_float(rr[0]), __uint_as_float(rr[1])); }
    constexpr float C2 = 1.4426950408889634f * SCALE;
    if (__builtin_expect(__all((pmax - m_reg) * SCALE <= THR), 1)) { mn = m_reg; alpha = 1.f; }
    else { mn = fmaxf(m_reg, pmax); alpha = __builtin_amdgcn_exp2f((m_reg - mn) * C2); m_reg = mn; }
    const float mnL = -mn * C2;
    for (int r = 0; r < 16; ++r) p0[r] = fmaf(p0[r], C2, mnL); for (int r = 0; r < 16; ++r) p1[r] = fmaf(p1[r], C2, mnL);
    for (int r = 0; r < 16; ++r) p0[r] = __builtin_amdgcn_exp2f(p0[r]);
}
__device__ __forceinline__ void finishSM(f32x16& p0, f32x16& p1, float alpha, float& l_reg, bf16x8& pa0, bf16x8& pa1, bf16x8& pa2, bf16x8& pa3) {
    for (int r = 0; r < 16; ++r) p1[r] = __builtin_amdgcn_exp2f(p1[r]);
    float ps = 0; for (int r = 0; r < 16; ++r) ps += p0[r]; for (int r = 0; r < 16; ++r) ps += p1[r];
    { auto rr = __builtin_amdgcn_permlane32_swap(__float_as_uint(ps), __float_as_uint(ps), false, false);
      ps = __uint_as_float(rr[0]) + __uint_as_float(rr[1]); }
    l_reg = l_reg * alpha + ps;
#define PK4(P, B_, OUT) do { unsigned a0 = cvt_pk_bf16(P[B_+0], P[B_+1]), a1 = cvt_pk_bf16(P[B_+2], P[B_+3]);                          \
        unsigned b0 = cvt_pk_bf16(P[B_+4], P[B_+5]), b1 = cvt_pk_bf16(P[B_+6], P[B_+7]);                                             \
        auto r0 = __builtin_amdgcn_permlane32_swap(a0, b0, false, false); auto r1 = __builtin_amdgcn_permlane32_swap(a1, b1, false, false); \
        u32x4 w = {r0[0], r1[0], r0[1], r1[1]}; OUT = *reinterpret_cast<bf16x8*>(&w); } while (0)
    PK4(p0, 0, pa0); PK4(p0, 8, pa1); PK4(p1, 0, pa2); PK4(p1, 8, pa3);
#undef PK4
}
template <int KB>
__device__ __forceinline__ void qkt(f32x16& p0, f32x16& p1, const char* K_lds, int r32, int hi, const bf16x8* qr) {
    p0 = f32x16{}; p1 = f32x16{};
    const char* kb[4];
#pragma unroll
    for (int dd = 0; dd < 4; ++dd) kb[dd] = K_lds + KB * SHM_K + KSWZ(r32, (dd * 16 + hi * 8) * 2);
#pragma unroll
    for (int d0 = 0; d0 < 8; ++d0) { const char* a = kb[d0 & 3] + (d0 >> 2) * 128;
        bf16x8 b0 = *reinterpret_cast<const bf16x8*>(a);
        bf16x8 b1 = *reinterpret_cast<const bf16x8*>(a + 32 * 256);
        p0 = __builtin_amdgcn_mfma_f32_32x32x16_bf16(b0, qr[d0], p0, 0, 0, 0);
        p1 = __builtin_amdgcn_mfma_f32_32x32x16_bf16(b1, qr[d0], p1, 0, 0, 0);
        if ((d0 & 3) == 3) SBAR(); }
}
template <int VB>
__device__ __forceinline__ void pv_tile(f32x16* o, int vb0, bf16x8 pa0, bf16x8 pa1, bf16x8 pa2, bf16x8 pa3) {
#define TRRD(dst, off) asm volatile("ds_read_b64_tr_b16 %0, %1 offset:%2" : "=&v"(dst) : "v"(vb0), "i"(off) : "memory")
#define PV_D0(d0) do { s16x4 l0, l1, l2, l3, h0, h1, h2, h3; constexpr int b_ = VB * SHM_V + v_rd_off(d0, 0, 0); \
        TRRD(l0, b_); TRRD(h0, b_ + 2048); TRRD(l1, b_ + 4096); TRRD(h1, b_ + 6144); TRRD(l2, b_ + 8192); TRRD(h2, b_ + 10240); TRRD(l3, b_ + 12288); TRRD(h3, b_ + 14336); \
        asm volatile("s_waitcnt lgkmcnt(0)" ::: "memory"); SBAR();   \
        o[d0] = __builtin_amdgcn_mfma_f32_32x32x16_bf16(pa0, (bf16x8){l0[0], l0[1], l0[2], l0[3], h0[0], h0[1], h0[2], h0[3]}, o[d0], 0, 0, 0);   \
        o[d0] = __builtin_amdgcn_mfma_f32_32x32x16_bf16(pa1, (bf16x8){l1[0], l1[1], l1[2], l1[3], h1[0], h1[1], h1[2], h1[3]}, o[d0], 0, 0, 0);   \
        o[d0] = __builtin_amdgcn_mfma_f32_32x32x16_bf16(pa2, (bf16x8){l2[0], l2[1], l2[2], l2[3], h2[0], h2[1], h2[2], h2[3]}, o[d0], 0, 0, 0);   \
        o[d0] = __builtin_amdgcn_mfma_f32_32x32x16_bf16(pa3, (bf16x8){l3[0], l3[1], l3[2], l3[3], h3[0], h3[1], h3[2], h3[3]}, o[d0], 0, 0, 0); } while (0)
    PV_D0(0); PV_D0(1); PV_D0(2); PV_D0(3);
#undef PV_D0
#undef TRRD
}

struct BlockRef { const bf16_t* Q; const bf16_t* K; const bf16_t* V; bf16_t* O; const unsigned long long* sel; int P0; int bt; };
struct Pitch { int ldq, ldkv, ldo; };
struct Seam { bf16x8 qr[8]; bf16x8 st_v0, st_v1, st_k0, st_k1; };

#define ROWU(p, k0) ((p) + (size_t)(k0) * PT.ldkv)
#define VMW() asm volatile("s_waitcnt vmcnt(0)" ::: "memory")
#define VMWN(n) asm volatile("s_waitcnt vmcnt(%0)" :: "i"(n) : "memory")
#define SLOAD_H(Kp, Vp, k0) do { S.st_v0 = load8b(ROWU(Vp, k0), ro0); S.st_v1 = load8b(ROWU(Vp, (k0) + 32), ro0);              \
                         S.st_k0 = load8b(ROWU(Kp, k0), ro0); S.st_k1 = load8b(ROWU(Kp, (k0) + 32), ro0); } while (0)
#define SWRITE_HK(bf) do { *(bf16x8*)(K_lds + (bf) * SHM_K + kws) = S.st_k0; *(bf16x8*)(K_lds + (bf) * SHM_K + kws + 32 * 256) = S.st_k1; } while (0)
#define SWRITE_HV(bf) do { *(bf16x8*)(V_lds + (bf) * SHM_V + vst0) = S.st_v0; *(bf16x8*)(V_lds + (bf) * SHM_V + vst0 + 8192) = S.st_v1; } while (0)
#define SWRITE_H(bf) do { SWRITE_HV(bf); SWRITE_HK(bf); } while (0)
__device__ __forceinline__ void prime(const BlockRef& cur, const Pitch& PT, char* lds, Seam& S, const int wid) {
    const int lane = fresh_lane(), tid = wid * 64 + lane, r32 = lane & 31, hi = lane >> 5;
    const int sr = tid >> 4, sc = (tid & 15) * 8, kws = KSWZ(sr, sc * 2); char* K_lds = lds + 2 * SHM_V;
    const unsigned ro0 = (unsigned)(sr * PT.ldkv + sc) * 2u, qo = (unsigned)((wid * QBLK + r32) * PT.ldq + hi * 8) * 2u;
#pragma unroll
    for (int d0 = 0; d0 < 8; ++d0) S.qr[d0] = load8b(cur.Q + d0 * 16, qo);
    SLOAD_H(cur.K, cur.V, 0); VMW(); SWRITE_HK(0);
    __syncthreads();
}
template <bool BIAS, bool SEL>
__device__ __forceinline__ void block(const BlockRef& cur, const BlockRef& nxt, int skv, const Pitch& PT, char* lds, Seam& S, const int wid) {
    const int lane = fresh_lane(), tid = wid * 64 + lane, r32 = lane & 31, hi = lane >> 5;
    int j_hi = (cur.P0 + QB - 1) / KVBLK + 1; if (j_hi > skv / KVBLK) j_hi = skv / KVBLK;
    const int NT = j_hi;
    const int qlo = cur.P0 + wid * QBLK, qm = qlo + r32 - 4 * hi;
    char* V_lds = lds; char* K_lds = lds + 2 * SHM_V;
    float* ws = (float*)(lds + 2 * SHM_V + 2 * SHM_K) + wid * 64; float* li_l = ws, * al_l = ws + 32;
    const float* btab = (const float*)(lds + BT_OFF) + cur.bt * BT_STRIDE;
    const unsigned selo = (unsigned)((wid * QBLK + r32) * 32) * 8u;
    unsigned long long selw = 0ull;
    float m_reg = -1e30f, l_reg = 0; f32x16 o[4] = {};
    const int sr = tid >> 4, sc = (tid & 15) * 8, vst0 = v_st(sr, sc), kws = KSWZ(sr, sc * 2);
    const int vb0 = (int)(uintptr_t)V_lds + v_rd_base(lane);
    const unsigned ro0 = (unsigned)(sr * PT.ldkv + sc) * 2u;
    const bf16_t* Kh = cur.K; const bf16_t* Vh = cur.V;
#define RESC(a) do { if (__any((a) < 1.f)) { if (hi == 0) al_l[r32] = (a); asm volatile("s_waitcnt lgkmcnt(0)" ::: "memory");              \
                     for (int d_ = 0; d_ < 4; ++d_) for (int r = 0; r < 16; ++r) o[d_][r] *= al_l[crow(r, hi)]; } } while (0)
#define KBASE(t) ((t) * KVBLK)
#define SELLD(t) do { if (SEL) selw = *(const unsigned long long*)((const char*)(cur.sel + (t)) + selo); } while (0)
#define MASKT(P0_, P1_, t) do { const int kb_ = KBASE(t); const int dq_ = qm - kb_; \
        if (kb_ + KVBLK - 1 > qlo) mask_causal(P0_, P1_, dq_); \
        if (BIAS && kb_ + KVBLK - 1 + 128 > qlo) add_bias(P0_, P1_, dq_, btab); \
        if (SEL) mask_sel(P0_, P1_, selw, hi); } while (0)
    constexpr int NQL = 8;
#define SEAM_K0() do { VMWN(NQL); SWRITE_HK(0); SBAR(); } while (0)
    f32x16 pA0, pA1, pB0, pB1; float mnA, mnB, alA, alB; bf16x8 pa0, pa1, pa2, pa3;
    SWRITE_HV(0); SBAR();
    SELLD(0);
    if (NT > 1) { SLOAD_H(Kh, Vh, KBASE(1)); }
    SBAR(); qkt<0>(pA0, pA1, K_lds, r32, hi, S.qr);
    MASKT(pA0, pA1, 0); partialSM(pA0, pA1, m_reg, mnA, alA);
    if (NT > 1) { VMW(); SWRITE_H(1); }
    __syncthreads();
#define HALF_STEP(PX0, PX1, mnX, alX, PY0, PY1, alY, t, KB, VB, SB) do {                                                      \
        SBAR(); SELLD(t); qkt<KB>(PX0, PX1, K_lds, r32, hi, S.qr);                                             \
        finishSM(PY0, PY1, alY, l_reg, pa0, pa1, pa2, pa3); SBAR();                                                           \
        if ((t) + 1 < NT) { SLOAD_H(Kh, Vh, KBASE((t) + 1)); SBAR(); }                                               \
        pv_tile<VB>(o, vb0, pa0, pa1, pa2, pa3); MASKT(PX0, PX1, (t)); partialSM(PX0, PX1, m_reg, mnX, alX);                                        \
        __syncthreads();                                                                                                      \
        if ((t) + 1 < NT) { VMW(); SWRITE_H(SB); }                                                                          \
        RESC(alX); __syncthreads(); } while (0)
    for (int t = 1; t + 1 < NT; t += 2) {
        HALF_STEP(pB0, pB1, mnB, alB, pA0, pA1, alA, t, 1, 0, 0);
        HALF_STEP(pA0, pA1, mnA, alA, pB0, pB1, alB, t + 1, 0, 1, 1);
    }
    const bool even = (NT & 1) == 0;
    if (even) { SBAR(); SELLD(NT - 1); qkt<1>(pB0, pB1, K_lds, r32, hi, S.qr); SBAR(); }
    SLOAD_H(nxt.K, nxt.V, 0); SBAR();
    { int t2 = wid * 64 + fresh_lane();
      const unsigned qo2 = (unsigned)((((t2 >> 6) * QBLK) + (t2 & 31)) * PT.ldq + ((t2 >> 5) & 1) * 8) * 2u;
#pragma unroll
      for (int d0 = 0; d0 < 8; ++d0) S.qr[d0] = load8b(nxt.Q + d0 * 16, qo2); }
    SBAR();
    finishSM(pA0, pA1, alA, l_reg, pa0, pa1, pa2, pa3); SBAR();
    pv_tile<0>(o, vb0, pa0, pa1, pa2, pa3);
    if (even) { MASKT(pB0, pB1, NT - 1); partialSM(pB0, pB1, m_reg, mnB, alB); __syncthreads(); RESC(alB);
        finishSM(pB0, pB1, alB, l_reg, pa0, pa1, pa2, pa3); SBAR(); pv_tile<1>(o, vb0, pa0, pa1, pa2, pa3); }
    SBAR(); SEAM_K0();
    if (hi == 0) li_l[r32] = l_reg; asm volatile("s_waitcnt lgkmcnt(0)" ::: "memory");
    float rli[16];
#pragma unroll
    for (int r = 0; r < 16; ++r) rli[r] = __builtin_amdgcn_rcpf(li_l[crow(r, hi)]);
    bf16_t* Ow = cur.O + (size_t)(wid * QBLK) * PT.ldo;
    int hi4 = 4 * hi; asm volatile("" : "+v"(hi4));
#pragma unroll
    for (int r = 0; r < 16; ++r) { const unsigned roff = ((unsigned)((r & 3) + 8 * (r >> 2) + hi4) * (unsigned)PT.ldo + r32) * 2u;
#pragma unroll
        for (int d0 = 0; d0 < 4; ++d0) { const float v = o[d0][r] * rli[r];
            const float vn = __shfl_xor(v, 1);
            if ((r32 & 1) == 0) *(unsigned*)((char*)(Ow + d0 * 32) + roff) = cvt_pk_bf16(v, vn); } }
    __syncthreads();
#undef RESC
#undef KBASE
#undef SELLD
#undef MASKT
#undef SEAM_K0
#undef HALF_STEP
}
#undef ROWU
#undef VMW
#undef VMWN
#undef SLOAD_H
#undef SWRITE_HK
#undef SWRITE_HV
#undef SWRITE_H
}
constexpr int NB = 4, T = 2048, DM = 2048, M = NB * T;
constexpr int NPROJ = 12880, LDP = 13056;
constexpr int C_QD = 0, C_KD = 2048, C_VD = 4096, C_QS = 6144, C_CKV = 7168, C_QI = 7680, C_KI = 8704, C_WI = 8768, C_GD = 8784, C_GS = 10832;
constexpr int NE = 64, NEX = 65, EDIM = 512, TOPK = 8;
constexpr int MAXTILES = 352, MAXROWS = MAXTILES * 256;
constexpr float LN_EPS = 1e-5f;
constexpr float DN_ALPHA = 1.189207115002721f;
constexpr float LAMBDA_INIT = 0.2f;
constexpr int NWAVES = 8;

constexpr size_t MiB = 1u << 20;
constexpr size_t WS_CTL = 0, CTL_ZERO_BYTES = 1 * MiB;
constexpr size_t WS_IDX = 1 * MiB;
constexpr size_t WS_WI = 2 * MiB;
constexpr size_t WS_KIB = 3 * MiB;
constexpr size_t WS_SIDE = 4 * MiB;
constexpr size_t WS_TOKL = 7 * MiB;
constexpr size_t WS_SELM = 9 * MiB;
constexpr size_t WS_WKVS = 12 * MiB;
constexpr size_t WS_WPD = 14 * MiB, WS_WPS = 22 * MiB, WS_WMO = 26 * MiB, WS_WXQ = 34 * MiB, WS_WXKV = 36 * MiB, WS_WXO = 40 * MiB;
constexpr size_t WS_MEMB = 42 * MiB, WS_CB = 46 * MiB, WS_HB = 54 * MiB, WS_MERGED = 86 * MiB, WS_OS = 118 * MiB, WS_KVS = 134 * MiB;
constexpr size_t WS_XQ = 134 * MiB, WS_XKV = 142 * MiB, WS_XO = 144 * MiB;
constexpr size_t WS_ODRAW = 166 * MiB, WS_OD = 230 * MiB;
constexpr size_t WS_W2T = 262 * MiB, WS_W13T = 392 * MiB;
constexpr size_t WS_WINT = 652 * MiB, WS_XB = 703 * MiB, WS_PROJ = 735 * MiB, WS_END = 939 * MiB;
constexpr size_t WS_OUTROWS = 392 * MiB;
constexpr size_t WS_ACT = 744 * MiB;
static_assert(WS_OUTROWS + (size_t)MAXROWS * 2048 * 2 <= WS_ACT && WS_ACT + (size_t)MAXROWS * 512 * 2 <= WS_END, "late overlays");
static_assert(WS_PROJ + (size_t)M * LDP * 2 <= WS_END && WS_WINT + (size_t)LDP * 2048 * 2 <= WS_XB, "early region");
constexpr int CW_BAR = 4096;
constexpr int CW_CNT = 16384;

constexpr int RING_OFF = 0, RING_BYTES = 131072;
constexpr int LDSCTL_OFF = RING_BYTES, MISC_OFF = LDSCTL_OFF + 320;
constexpr int LDS_BYTES = 147456;

#define RLX_AGENT __ATOMIC_RELAXED, __HIP_MEMORY_SCOPE_AGENT
#define LDS_WAIT() asm volatile("s_waitcnt lgkmcnt(0)" ::: "memory")
#define VM_WAIT() asm volatile("s_waitcnt vmcnt(0)" ::: "memory")

#define XB_TMO      128
#define XB_XCNT(j)  (256  + 64 * (j))
#define XB_XSUB(j)  (1280 + 64 * (j))
#define XB_XGEN(j)  (2304 + 64 * (j))
#define XB_TOP      3328
#define XB_TOPGEN   3392
#define XCD_BAR_WORDS 3456
#define XB_SPIN_CAP (1u << 22)
__device__ __forceinline__ unsigned xb_ld(unsigned* p)              { return __hip_atomic_load(p, __ATOMIC_RELAXED, __HIP_MEMORY_SCOPE_AGENT); }
__device__ __forceinline__ unsigned xb_add(unsigned* p, unsigned v) { return __hip_atomic_fetch_add(p, v, __ATOMIC_RELAXED, __HIP_MEMORY_SCOPE_AGENT); }
__device__ __forceinline__ unsigned xb_xcc_id() { return (unsigned)__builtin_amdgcn_s_getreg((3 << 11) | 20) & 0xFu; }
#define XB_SPIN(cond, bar) do { unsigned _sp = 0; while (cond) { __builtin_amdgcn_s_sleep(1); \
    if ((++_sp & 255u) == 0u) { if (xb_ld(&(bar)[XB_TMO])) break; if (_sp > XB_SPIN_CAP) { atomicAdd(&(bar)[XB_TMO], 1u); break; } } } } while (0)
struct XcdBarrier { unsigned* bar; unsigned x; volatile LAS unsigned* st; int wave; };
__device__ __forceinline__ XcdBarrier xcd_barrier_post(unsigned* bar, volatile LAS unsigned* st, int wave) {
    XcdBarrier b; b.bar = bar; b.x = xb_xcc_id(); b.st = st; b.wave = wave;
    if (wave == 0 && fresh_lane() == 0) (void)xb_add(&bar[XB_XCNT(b.x)], 1u);
    return b;
}
__device__ __forceinline__ void xcd_barrier_complete(unsigned* bar, unsigned x, unsigned& nloc, unsigned& nx) {
    const unsigned G = gridDim.x * gridDim.y * gridDim.z;
    unsigned sum, cnt, mine, sp = 0u;
    for (;;) {
        sum = 0u; cnt = 0u; mine = 0u;
#pragma unroll
        for (unsigned j = 0; j < 16; ++j) { const unsigned c = xb_ld(&bar[XB_XCNT(j)]); sum += c; cnt += (c > 0u) ? 1u : 0u; mine = (j == x) ? c : mine; }
        if (sum == G) break;
        __builtin_amdgcn_s_sleep(1);
        if ((++sp & 255u) == 0u) { if (xb_ld(&bar[XB_TMO])) break; if (sp > XB_SPIN_CAP) { atomicAdd(&bar[XB_TMO], 1u); break; } }
    }
    nloc = mine > 0u ? mine : 1u; nx = cnt > 0u ? cnt : 1u;
}
__device__ __forceinline__ void xcd_barrier(const XcdBarrier& b) {
    asm volatile("s_waitcnt vmcnt(0)" ::: "memory");
    __syncthreads();
    if (b.wave == 0 && fresh_lane() == 0) {
        unsigned* bar = b.bar;
        __builtin_amdgcn_s_waitcnt(0);
        unsigned nloc = b.st[0], nx = b.st[1];
        if (nloc == 0u) { xcd_barrier_complete(bar, b.x, nloc, nx); b.st[0] = nloc; b.st[1] = nx; }
        const unsigned old = xb_add(&bar[XB_XSUB(b.x)], 1u);
        const unsigned gen = old / nloc;
        if (old + 1u == (gen + 1u) * nloc) {
            __builtin_amdgcn_fence(__ATOMIC_RELEASE, "agent");
            asm volatile("s_waitcnt vmcnt(0)" ::: "memory");
            const unsigned og = xb_add(&bar[XB_TOP], 1u);
            const unsigned tg = og / nx;
            if (og + 1u == (tg + 1u) * nx) xb_add(&bar[XB_TOPGEN], 1u);
            else XB_SPIN(xb_ld(&bar[XB_TOPGEN]) == tg, bar);
            __builtin_amdgcn_fence(__ATOMIC_ACQUIRE, "agent");
            xb_add(&bar[XB_XGEN(b.x)], 1u);
            asm volatile("s_waitcnt vmcnt(0)" ::: "memory");
        } else {
            XB_SPIN(xb_ld(&bar[XB_XGEN(b.x)]) == gen, bar);
            __builtin_amdgcn_fence(__ATOMIC_ACQUIRE, "agent");
            asm volatile("s_waitcnt vmcnt(0)" ::: "memory");
        }
    }
    __syncthreads();
}

struct Args { const float* in[32]; float* out; unsigned char* ws; int ph_lo, ph_hi; };
struct Frame {
    LAS unsigned char* lds; char* ldsg;
    unsigned* ctl;
    int tid, lane, wave, vcu, G;
    const __attribute__((address_space(4))) char* ka;
    float* out; unsigned char* ws;
};
#define INP(i) (*(const float* const __attribute__((address_space(4)))*)(F.ka + 8 * (i)))
#define WSP(T_, off) ((T_*)(F.ws + (off)))

__device__ __forceinline__ void p0_transpose_item(const float* src, int ldn, int nvalid, int k0, int n0, bf16_t* dst, size_t drow0, int Kd, LAS float* scr, int lane) {
    int nn = n0 + (lane & 31); nn = nn < nvalid ? nn : nvalid - 1;
#pragma unroll 8
    for (int i = 0; i < 32; ++i) { const int kk = 2 * i + (lane >> 5); scr[kk * 33 + (lane & 31)] = src[(size_t)(k0 + kk) * ldn + nn]; }
    LDS_WAIT(); asm volatile("" ::: "memory");
    const int c = lane & 7;
#pragma unroll
    for (int j = 0; j < 4; ++j) { const int n = (lane >> 3) + 8 * j; const LAS float* s = scr + (8 * c) * 33 + n;
        u32x4 o; o.x = cvt_pk_bf16(s[0 * 33], s[1 * 33]); o.y = cvt_pk_bf16(s[2 * 33], s[3 * 33]); o.z = cvt_pk_bf16(s[4 * 33], s[5 * 33]); o.w = cvt_pk_bf16(s[6 * 33], s[7 * 33]);
        *(u32x4*)(dst + (drow0 + n) * Kd + k0 + 8 * c) = o; }
    LDS_WAIT(); asm volatile("" ::: "memory");
}
__device__ __forceinline__ void cvt_row(const float* s, bf16_t* d, int n, int lane) {
    for (int i = lane * 8; i < n; i += 512) { const f32x4 a = *(const f32x4*)(s + i), b = *(const f32x4*)(s + i + 4); *(u32x4*)(d + i) = pg8::pack8(a, b); }
}
constexpr int I_E = 512, I_EXP = 3 * I_E * NEX;
#ifndef EXP_X1
#define EXP_X1 25600
#define EXP_X2 76800
#define EXP_X3 99840
#endif
constexpr int EXP_P0_FROM = EXP_X3;
__device__ __forceinline__ void p0_expert_item(Frame& F, int r, LAS float* scr, int lane) {
    const int e = r / (3 * I_E), q = r % (3 * I_E), which = q / I_E, s = q % I_E;
    if (which < 2) {
        const float* src = e < NE ? INP(which == 0 ? 24 : 25) + (size_t)e * 2048 * 512 : INP(which == 0 ? 27 : 28);
        const int kb = s / 16, nb = s % 16, n0 = nb * 32;
        p0_transpose_item(src, 512, 512, kb * 64, n0, WSP(bf16_t, WS_W13T) + (size_t)e * 1024 * 2048, (size_t)((n0 >> 7) * 256 + which * 128 + (n0 & 127)), 2048, scr, lane);
    } else {
        const float* src = e < NE ? INP(26) + (size_t)e * 512 * 2048 : INP(29);
        const int kb = s / 64, nb = s % 64;
        p0_transpose_item(src, 2048, 2048, kb * 64, nb * 32, WSP(bf16_t, WS_W2T) + (size_t)e * 2048 * 512, (size_t)(nb * 32), 512, scr, lane);
    }
}
__device__ __forceinline__ void expert_filler(Frame& F, int lo, int hi_, int hidx, int nh) {
    LAS float* scr = (LAS float*)(F.lds + RING_OFF + F.wave * 16384);
    const int lane = fresh_lane();
    for (int r = lo + hidx * NWAVES + F.wave; r < hi_; r += nh * NWAVES) p0_expert_item(F, r, scr, lane);
}
__device__ __forceinline__ void p0_prologue(Frame& F) {
    LAS float* scr = (LAS float*)(F.lds + RING_OFF + F.wave * 16384);
    const int gw = F.vcu * NWAVES + F.wave, NGW = F.G * NWAVES, lane = F.lane;
    constexpr int I_WIN = 32 * 403, I_PD = 32 * 64, I_PS = 16 * 64, I_MO = 32 * 64, I_XQ = 32 * 16, I_XKV = 32 * 32, I_XO = 8 * 64, I_UV = 8 * 32, I_UK = 1024;
    constexpr int I_X = M, I_MEM = 1024;
    constexpr int NITEMS = I_EXP + I_WIN + I_PD + I_PS + I_MO + I_XQ + I_XKV + I_XO + I_UV + I_UK + I_X + I_MEM;
    for (int it = gw; it < NITEMS; it += NGW) {
        int r = it;
        if (r < I_EXP) { if (r >= EXP_P0_FROM) p0_expert_item(F, r, scr, lane); continue; }
        r -= I_EXP;
        if (r < I_WIN) { const int kb = r / 403, nb = r % 403; p0_transpose_item(INP(4), NPROJ, NPROJ, kb * 64, nb * 32, WSP(bf16_t, WS_WINT), (size_t)(nb * 32), 2048, scr, lane); continue; } r -= I_WIN;
        if (r < I_PD) { const int kb = r / 64, nb = r % 64; p0_transpose_item(INP(12), 2048, 2048, kb * 64, nb * 32, WSP(bf16_t, WS_WPD), (size_t)(nb * 32), 2048, scr, lane); continue; } r -= I_PD;
        if (r < I_PS) { const int kb = r / 64, nb = r % 64; p0_transpose_item(INP(13), 2048, 2048, kb * 64, nb * 32, WSP(bf16_t, WS_WPS), (size_t)(nb * 32), 1024, scr, lane); continue; } r -= I_PS;
        if (r < I_MO) { const int kb = r / 64, nb = r % 64; p0_transpose_item(INP(14), 2048, 2048, kb * 64, nb * 32, WSP(bf16_t, WS_WMO), (size_t)(nb * 32), 2048, scr, lane); continue; } r -= I_MO;
        if (r < I_XQ) { const int kb = r / 16, nb = r % 16; p0_transpose_item(INP(17), 512, 512, kb * 64, nb * 32, WSP(bf16_t, WS_WXQ), (size_t)(nb * 32), 2048, scr, lane); continue; } r -= I_XQ;
        if (r < I_XKV) { const int kb = r / 32, nb = r % 32; p0_transpose_item(INP(18), 1024, 1024, kb * 64, nb * 32, WSP(bf16_t, WS_WXKV), (size_t)(nb * 32), 2048, scr, lane); continue; } r -= I_XKV;
        if (r < I_XO) { const int kb = r / 64, nb = r % 64; p0_transpose_item(INP(19), 2048, 2048, kb * 64, nb * 32, WSP(bf16_t, WS_WXO), (size_t)(nb * 32), 512, scr, lane); continue; } r -= I_XO;
        if (r < I_UV) { const int h = r / 32, s = r % 32, kb = s / 4, nb = s % 4;
            p0_transpose_item(INP(11) + (size_t)h * 512 * 128, 128, 128, kb * 64, nb * 32, WSP(bf16_t, WS_WKVS), (size_t)(1024 + h * 128 + nb * 32), 512, scr, lane); continue; } r -= I_UV;
        if (r < I_UK) { cvt_row(INP(10) + (size_t)r * 512, WSP(bf16_t, WS_WKVS) + (size_t)r * 512, 512, lane); continue; } r -= I_UK;
        if (r < I_X) { cvt_row(INP(0) + (size_t)r * DM, WSP(bf16_t, WS_XB) + (size_t)r * DM, DM, lane); continue; } r -= I_X;
        cvt_row(INP(1) + (size_t)r * DM, WSP(bf16_t, WS_MEMB) + (size_t)r * DM, DM, lane);
    }
}

__device__ __forceinline__ void p2_token_norms(Frame& F) {
    const int gw = F.vcu * NWAVES + F.wave, NGW = F.G * NWAVES, lane = F.lane;
    const bf16_t* proj = WSP(bf16_t, WS_PROJ); const float* side = WSP(float, WS_SIDE);
    const float* kvg = INP(9); const float* kg = INP(7); const float* kb = INP(8);
    for (int t = gw; t < M; t += NGW) {
        const u32x4 w = *(const u32x4*)(proj + (size_t)t * LDP + C_CKV + lane * 8);
        float v[8] = {bf_lo(w.x), bf_hi(w.x), bf_lo(w.y), bf_hi(w.y), bf_lo(w.z), bf_hi(w.z), bf_lo(w.w), bf_hi(w.w)};
        float ss = 0.f;
#pragma unroll
        for (int j = 0; j < 8; ++j) ss += v[j] * v[j];
        const float rstd = 1.0f / sqrtf(wave_sum(ss) * (1.0f / 512.0f) + LN_EPS);
        const f32x4 g0 = *(const f32x4*)(kvg + lane * 8), g1 = *(const f32x4*)(kvg + lane * 8 + 4);
        f32x4 o0 = {v[0] * rstd * g0[0], v[1] * rstd * g0[1], v[2] * rstd * g0[2], v[3] * rstd * g0[3]};
        f32x4 o1 = {v[4] * rstd * g1[0], v[5] * rstd * g1[1], v[6] * rstd * g1[2], v[7] * rstd * g1[3]};
        *(u32x4*)(WSP(bf16_t, WS_CB) + (size_t)t * 512 + lane * 8) = pg8::pack8(o0, o1);
        const float kv = side[(size_t)t * 80 + lane];
        const float mu = wave_sum(kv) * (1.0f / 64.0f); const float dv = kv - mu;
        const float var = wave_sum(dv * dv) * (1.0f / 64.0f);
        const float kn = dv * (1.0f / sqrtf(var + LN_EPS)) * kg[lane] + kb[lane];
        const float kn2 = __shfl_xor(kn, 1);
        if ((lane & 1) == 0) *(unsigned*)(WSP(bf16_t, WS_KIB) + (size_t)t * 64 + lane) = cvt_pk_bf16(kn, kn2);
        if (lane < 16) WSP(float, WS_WI)[(size_t)t * 16 + lane] = side[(size_t)t * 80 + 64 + lane] * (1.0f / 32.0f);
    }
}

__device__ __forceinline__ unsigned fkey(float f) { const unsigned u = __builtin_bit_cast(unsigned, f); return (u & 0x80000000u) ? ~u : (u | 0x80000000u); }
template <int MODE>
__device__ __forceinline__ void p3_indexer(Frame& F) {
    const int lane = F.lane, wave = F.wave, c = lane & 31, hi = lane >> 5;
    const bf16_t* proj = WSP(bf16_t, WS_PROJ); const bf16_t* kib = WSP(bf16_t, WS_KIB); const float* wi = WSP(float, WS_WI);
    float* scr = F.out + ((size_t)blockIdx.x * NWAVES + wave) * (4 * 2048);
    unsigned long long* selm = WSP(unsigned long long, WS_SELM);
    for (int unit = blockIdx.x; unit < NB * 64; unit += F.G) {
        const int b = unit >> 6, y = unit & 63;
        const int tile = (wave < 4) ? y : 127 - y;
        const int t0 = tile * 16 + (wave & 3) * 4;
        bf16x8 af[2][4]; float wv[2][16];
        const int atok = (c >> 2) & 1, ahead = (c & 3) + 4 * (c >> 3);
#pragma unroll
        for (int mb = 0; mb < 2; ++mb) {
            const bf16_t* qp = proj + (size_t)(b * T + t0 + 2 * mb + atok) * LDP + C_QI + ahead * 64 + hi * 8;
#pragma unroll
            for (int ks = 0; ks < 4; ++ks) af[mb][ks] = *(const bf16x8*)(qp + ks * 16);
            const float* wp = wi + (size_t)(b * T + t0 + 2 * mb + hi) * 16;
#pragma unroll
            for (int r = 0; r < 16; ++r) wv[mb][r] = wp[(r & 3) + 4 * (r >> 2)];
        }
        const int nkb = (t0 + 3) / 32 + 1;
        const bf16_t* kp0 = kib + (size_t)(b * T + c) * 64 + hi * 8;
        bf16x8 bq[4][4];
#define IDX_LOAD(s, kb_) do { _Pragma("unroll") for (int ks = 0; ks < 4; ++ks) bq[s][ks] = *(const bf16x8*)(kp0 + (size_t)(kb_) * 2048 + ks * 16); } while (0)
#define IDX_STEP(s, kb_) do { if ((kb_) < nkb) { \
            _Pragma("unroll") for (int mb = 0; mb < 2; ++mb) { f32x16 acc = {}; \
                _Pragma("unroll") for (int ks = 0; ks < 4; ++ks) acc = __builtin_amdgcn_mfma_f32_32x32x16_bf16(af[mb][ks], bq[s][ks], acc, 0, 0, 0); \
                float sc_ = 0.f; \
                _Pragma("unroll") for (int r = 0; r < 16; ++r) sc_ = fmaf(fmaxf(acc[r], 0.f), wv[mb][r], sc_); \
                scr[(2 * mb + hi) * 2048 + (kb_) * 32 + c] = sc_; } \
            if ((kb_) + 4 < nkb) IDX_LOAD(s, (kb_) + 4); } } while (0)
        if (MODE & 1) {
#pragma unroll
        for (int s = 0; s < 4; ++s) if (s < nkb) IDX_LOAD(s, s);
        for (int kb = 0; kb < nkb; kb += 4) { IDX_STEP(0, kb); IDX_STEP(1, kb + 1); IDX_STEP(2, kb + 2); IDX_STEP(3, kb + 3); } }
#undef IDX_LOAD
#undef IDX_STEP
        VM_WAIT();
        if (MODE & 2)
#pragma unroll 1
        for (int qp = 0; qp < 4; qp += 2) {
        unsigned keys[2][32];
#pragma unroll
        for (int q2 = 0; q2 < 2; ++q2) { const int nvalid = t0 + qp + q2 + 1; const float* row = scr + (qp + q2) * 2048;
#pragma unroll
            for (int j = 0; j < 32; ++j) keys[q2][j] = __builtin_bit_cast(unsigned, __builtin_nontemporal_load(row + j * 64 + lane));
#pragma unroll
            for (int j = 0; j < 32; ++j) { const int k = j * 64 + lane; unsigned u = keys[q2][j]; asm volatile("" : "+v"(u));
                keys[q2][j] = (k < nvalid) ? fkey(__builtin_bit_cast(float, u)) : 0u; } }
#pragma unroll
        for (int q2 = 0; q2 < 2; ++q2) {
            const int t = t0 + qp + q2, nvalid = t + 1;
            unsigned (&key)[32] = keys[q2];
            const int nj = (nvalid + 63) >> 6;
            unsigned thr = 1u;
            if (nvalid > 256) {
                thr = 0u;
                for (int bit = 31; bit >= 0; --bit) {
                    const unsigned cand = thr | (1u << bit); unsigned cl = 0u;
#pragma unroll
                    for (int j = 0; j < 32; ++j) if (j < nj) cl += (key[j] >= cand) ? 1u : 0u;
                    int cnt = 0;
#pragma unroll
                    for (int bb = 0; bb < 6; ++bb) cnt += __popcll(__ballot((cl >> bb) & 1u)) << bb;
                    if (cnt >= 256) thr = cand;
                    if (cnt == 256) break;
                }
            }
            unsigned mlo = 0u, mhi = 0u;
#pragma unroll
            for (int j = 0; j < 32; ++j) { const unsigned long long bm = __ballot(key[j] >= thr && key[j] != 0u);
                asm volatile("v_writelane_b32 %0, %2, %4\n\tv_writelane_b32 %1, %3, %4" : "+v"(mlo), "+v"(mhi) : "s"((unsigned)bm), "s"((unsigned)(bm >> 32)), "n"(j)); }
            if (lane < 32) selm[(size_t)(b * T + t) * 32 + lane] = ((unsigned long long)mhi << 32) | mlo;
        }
        }
    }
}

__device__ __forceinline__ void write_bias_table(Frame& F, const float* table, int col, int which) {
    float* bt = (float*)(F.ldsg + att::BT_OFF) + which * att::BT_STRIDE;
    const int rel = F.wave * 64 + fresh_lane();
    if (rel <= 128) {
        int bucket;
        if (rel < 16) bucket = rel;
        else { const float nf = (float)rel; int lg = 16 + (int)(logf(nf / 16.0f) / 2.0794415416798357f * 16.0f); bucket = lg < 31 ? lg : 31; }
        bt[rel] = (table[bucket * 16 + col] - table[31 * 16 + col]) * (1.0f / att::SCALE);
    }
}
__device__ __forceinline__ att::BlockRef self_ref(Frame& F, int job, int qb) {
    att::BlockRef r; const bf16_t* proj = WSP(bf16_t, WS_PROJ);
    if (job < 128) { const int b = job >> 5, h = (job >> 2) & 7, cmap = (job >> 1) & 1, half = job & 1;
        const size_t base = (size_t)b * T * LDP;
        r.Q = proj + base + (size_t)qb * 256 * LDP + C_QD + h * 256 + cmap * 128;
        r.K = proj + base + C_KD + h * 256 + cmap * 128;
        r.V = proj + base + C_VD + h * 256 + half * 128;
        r.O = WSP(bf16_t, WS_ODRAW) + (size_t)cmap * M * 2048 + (size_t)(b * T + qb * 256) * 2048 + h * 256 + half * 128;
        r.sel = nullptr; r.bt = h;
    } else { const int j = job - 128, b = j >> 3, h = j & 7;
        r.Q = proj + (size_t)(b * T + qb * 256) * LDP + C_QS + h * 128;
        r.K = WSP(bf16_t, WS_KVS) + (size_t)b * T * 2048 + h * 128;
        r.V = WSP(bf16_t, WS_KVS) + (size_t)b * T * 2048 + 1024 + h * 128;
        r.O = WSP(bf16_t, WS_OS) + (size_t)(b * T + qb * 256) * 1024 + h * 128;
        r.sel = WSP(unsigned long long, WS_SELM) + (size_t)(b * T + qb * 256) * 32; r.bt = 8 + h;
    }
    r.P0 = qb * 256;
    return r;
}
__device__ __forceinline__ att::BlockRef decode_self(Frame& F, int job_lo, int L_, int pass_, int& col) {
    const int job = job_lo + (L_ >> 2), y = L_ & 3; att::BlockRef r = self_ref(F, job, pass_ ? 7 - y : y); col = r.bt; return r; }
__device__ __forceinline__ att::BlockRef decode_cross(Frame& F, int L_) { const int b = L_ >> 5, h = (L_ >> 3) & 3, qb = L_ & 7; att::BlockRef r;
    r.Q = WSP(bf16_t, WS_XQ) + (size_t)(b * T + qb * 256) * 512 + h * 128;
    r.K = WSP(bf16_t, WS_XKV) + (size_t)b * 256 * 1024 + h * 128;
    r.V = WSP(bf16_t, WS_XKV) + (size_t)b * 256 * 1024 + 512 + h * 128;
    r.O = WSP(bf16_t, WS_XO) + (size_t)(b * T + qb * 256) * 512 + h * 128;
    r.sel = nullptr; r.bt = 0; r.P0 = 4096; return r; }
template <bool SEL>
__device__ __forceinline__ void attn_self_phase(Frame& F, int job_lo, int job_hi) {
    const int nitems = (job_hi - job_lo) * 4, stride = F.G;
    int L = blockIdx.x; if (L >= nitems) return;
    const float* table = INP(3);
    int pass = 0, slot = 0;
    int col; att::BlockRef cur = decode_self(F, job_lo, L, 0, col); cur.bt = slot;
    const att::Pitch PT{LDP, SEL ? 2048 : LDP, SEL ? 1024 : 2048};
    write_bias_table(F, table, col, slot);
    att::Seam S;
    att::prime(cur, PT, F.ldsg, S, F.wave);
    for (;;) {
        const bool more_pass = pass == 0, more_item = L + stride < nitems, last = !more_pass && !more_item;
        int passn = pass + 1, Ln = L;
        if (!more_pass) { passn = 0; Ln = more_item ? L + stride : L; }
        att::BlockRef nxt = cur; int coln = col;
        if (!last) { nxt = decode_self(F, job_lo, Ln, passn, coln); nxt.bt = slot ^ 1; write_bias_table(F, table, coln, slot ^ 1); }
        att::block<true, SEL>(cur, nxt, T, PT, F.ldsg, S, F.wave);
        if (last) break;
        cur = nxt; pass = passn; L = Ln; slot ^= 1; col = coln;
    }
}
__device__ __forceinline__ void attn_cross_phase(Frame& F) {
    const int nitems = NB * 4 * 8, stride = F.G;
    int L = blockIdx.x; if (L >= nitems) return;
    att::BlockRef cur = decode_cross(F, L);
    const att::Pitch PT{512, 1024, 512};
    att::Seam S;
    att::prime(cur, PT, F.ldsg, S, F.wave);
    for (;;) {
        const bool last = L + stride >= nitems;
        const att::BlockRef nxt = last ? cur : decode_cross(F, L + stride);
        att::block<false, false>(cur, nxt, 256, PT, F.ldsg, S, F.wave);
        if (last) break;
        cur = nxt; L += stride;
    }
}

__device__ __forceinline__ void p5_diff_combine(Frame& F) {
    const int gw = F.vcu * NWAVES + F.wave, NGW = F.G * NWAVES, lane = F.lane;
    const float* dl = INP(5);
    const float s1 = wave_sum(dl[lane] * dl[128 + lane] + dl[64 + lane] * dl[192 + lane]);
    const float s2 = wave_sum(dl[256 + lane] * dl[384 + lane] + dl[320 + lane] * dl[448 + lane]);
    const float lam = expf(s1) - expf(s2) + LAMBDA_INIT;
    const f32x4 g = *(const f32x4*)(INP(6) + lane * 4);
    const bf16_t* o0 = WSP(bf16_t, WS_ODRAW); const bf16_t* o1 = o0 + (size_t)M * 2048; bf16_t* od = WSP(bf16_t, WS_OD);
    for (int it = gw; it < M * 8; it += NGW) {
        const size_t off = (size_t)it * 256 + lane * 4;
        const u32x2 a = *(const u32x2*)(o0 + off), b = *(const u32x2*)(o1 + off);
        float v[4] = {bf_lo(a.x) - lam * bf_lo(b.x), bf_hi(a.x) - lam * bf_hi(b.x), bf_lo(a.y) - lam * bf_lo(b.y), bf_hi(a.y) - lam * bf_hi(b.y)};
        const float ss = wave_sum(v[0] * v[0] + v[1] * v[1] + v[2] * v[2] + v[3] * v[3]);
        const float rs = (1.0f / sqrtf(ss * (1.0f / 256.0f) + LN_EPS)) * (1.0f - LAMBDA_INIT);
        u32x2 w; w.x = cvt_pk_bf16(v[0] * rs * g[0], v[1] * rs * g[1]); w.y = cvt_pk_bf16(v[2] * rs * g[2], v[3] * rs * g[3]);
        *(u32x2*)(od + off) = w;
    }
}

__device__ __forceinline__ void ln_phase(Frame& F, float* H, const float* g, const float* bta, bf16_t* HB, float* Hdst) {
    const int gw = F.vcu * NWAVES + F.wave, NGW = F.G * NWAVES, lane = F.lane;
    for (int m = gw; m < M; m += NGW) {
        f32x4* xr = (f32x4*)(H + (size_t)m * DM) + lane;
        f32x4 v[8]; float s = 0.f;
#pragma unroll
        for (int j = 0; j < 8; ++j) { v[j] = xr[64 * j]; s += (v[j].x + v[j].y) + (v[j].z + v[j].w); }
        const float mean = wave_sum(s) * (1.f / DM); float s2 = 0.f;
#pragma unroll
        for (int j = 0; j < 8; ++j) { v[j] = v[j] - mean; s2 += (v[j].x * v[j].x + v[j].y * v[j].y) + (v[j].z * v[j].z + v[j].w * v[j].w); }
        const float rstd = 1.f / sqrtf(wave_sum(s2) * (1.f / DM) + LN_EPS);
#pragma unroll
        for (int j = 0; j < 8; ++j) { const f32x4 gg = *((const f32x4*)g + lane + 64 * j), bb = *((const f32x4*)bta + lane + 64 * j);
            const f32x4 o = v[j] * rstd * gg + bb; ((f32x4*)(Hdst + (size_t)m * DM) + lane)[64 * j] = o;
            if (HB) { u32x2 w; w.x = cvt_pk_bf16(o.x, o.y); w.y = cvt_pk_bf16(o.z, o.w); *((u32x2*)(HB + (size_t)m * DM) + lane + 64 * j) = w; } }
    }
}

__device__ __forceinline__ float rl_f(float v, int l) { return __builtin_bit_cast(float, __builtin_amdgcn_readlane(__builtin_bit_cast(int, v), l)); }
__device__ __forceinline__ void p13_router(Frame& F, unsigned* cnt, int* idxo, int* tokl) {
    const int lane = F.lane, wave = F.wave, c = lane & 31, hi = lane >> 5, tid = F.tid;
    const float* H = F.out; const float* rw = INP(22); const float* rbias = INP(23);
    LAS float* red = (LAS float*)(F.lds + RING_OFF);
    LAS float* lg = red + 8 * 32 * 64; LAS int* pk_e = (LAS int*)(lg + 32 * 65); LAS int* pk_slot = pk_e + 256; LAS float* pk_gate = (LAS float*)(pk_slot + 256);
    LAS int* lcnt = (LAS int*)(pk_gate + 256); LAS int* lbase = lcnt + 64;
    int* sloto = idxo + M * 8; float* gateo = (float*)(sloto + M * 8);
    const float mybias = rbias[lane];
    for (int unit = blockIdx.x; unit < M / 32; unit += F.G) {
        const int t0 = unit * 32;
        f32x16 a0 = {}, a1 = {};
        const float* hp = H + (size_t)(t0 + c) * DM + wave * 256 + 4 * hi;
        const float* wp = rw + (size_t)(wave * 256 + 4 * hi) * 64 + c;
#pragma unroll 4
        for (int gI = 0; gI < 32; ++gI) {
            const f32x4 av = *(const f32x4*)(hp + gI * 8);
#pragma unroll
            for (int j = 0; j < 4; ++j) { const float b0 = wp[(size_t)(gI * 8 + j) * 64], b1 = wp[(size_t)(gI * 8 + j) * 64 + 32];
                a0 = __builtin_amdgcn_mfma_f32_32x32x2f32(av[j], b0, a0, 0, 0, 0);
                a1 = __builtin_amdgcn_mfma_f32_32x32x2f32(av[j], b1, a1, 0, 0, 0); }
        }
        if (tid < 64) lcnt[tid] = 0;
#pragma unroll
        for (int r = 0; r < 16; ++r) { const int tok = (r & 3) + 8 * (r >> 2) + 4 * hi; red[(wave * 32 + tok) * 64 + c] = a0[r]; red[(wave * 32 + tok) * 64 + 32 + c] = a1[r]; }
        __syncthreads();
        for (int p = tid; p < 32 * 64; p += 512) { float s = 0.f;
#pragma unroll
            for (int w = 0; w < 8; ++w) s += red[w * 2048 + p];
            lg[(p >> 6) * 65 + (p & 63)] = s; }
        __syncthreads();
#pragma unroll 1
        for (int q = 0; q < 4; ++q) {
            const int tok = wave * 4 + q;
            const float s = sigmoidf_(lg[tok * 65 + lane]); const float sel = s + mybias;
            float m1 = sel; m1 = fmaxf(m1, __shfl_xor(m1, 1)); m1 = fmaxf(m1, __shfl_xor(m1, 2)); m1 = fmaxf(m1, __shfl_xor(m1, 4));
            const unsigned long long eqm = __ballot(sel == m1);
            const int grp = lane >> 3; const unsigned gb = (unsigned)(eqm >> (8 * grp)) & 0xffu; const int first = __ffs((int)gb) - 1;
            float m2 = ((lane & 7) == first) ? -__builtin_inff() : sel; m2 = fmaxf(m2, __shfl_xor(m2, 1)); m2 = fmaxf(m2, __shfl_xor(m2, 2)); m2 = fmaxf(m2, __shfl_xor(m2, 4));
            const float gs = m1 + m2;
            int grank = 0;
#pragma unroll
            for (int j = 0; j < 8; ++j) { const float gj = rl_f(gs, 8 * j); grank += (gj > gs || (gj == gs && j < grp)) ? 1 : 0; }
            const bool gsel = grank < 4;
            const float cv = gsel ? sel : -__builtin_inff();
            int rank = 0;
#pragma unroll
            for (int j = 0; j < 64; ++j) { const float vj = rl_f(cv, j); rank += (vj > cv || (vj == cv && j < lane)) ? 1 : 0; }
            const bool pick = gsel && rank < 8;
            const float gsum = wave_sum(pick ? s : 0.f);
            if (pick) { pk_e[tok * 8 + rank] = lane; pk_gate[tok * 8 + rank] = s / gsum * 2.5f;
                pk_slot[tok * 8 + rank] = __hip_atomic_fetch_add(lcnt + lane, 1, __ATOMIC_RELAXED, __HIP_MEMORY_SCOPE_WORKGROUP); }
        }
        __syncthreads();
        if (tid < 64) lbase[tid] = (int)__hip_atomic_fetch_add(cnt + 64 * tid, (unsigned)lcnt[tid], RLX_AGENT);
        __syncthreads();
        if (tid < 256) { const int t = t0 + (tid >> 3); const int e = pk_e[tid], sl = lbase[e] + pk_slot[tid];
            idxo[t * 8 + (tid & 7)] = e; sloto[t * 8 + (tid & 7)] = sl; gateo[t * 8 + (tid & 7)] = pk_gate[tid]; tokl[e * 8192 + sl] = t; }
        __syncthreads();
    }
}

struct MoeTab { LAS int* tb; LAS int* cn; };
__device__ __forceinline__ void moe_build_tab(Frame& F, const MoeTab& mt) {
    if (F.tid == 0) { int acc = 0;
        for (int e = 0; e < NE; ++e) { const int cnum = (int)__hip_atomic_load(F.ctl + CW_CNT + 64 * e, RLX_AGENT); mt.cn[e] = cnum; mt.tb[e] = acc; acc += (cnum + 255) >> 8; }
        mt.cn[NE] = M; mt.tb[NE] = acc; acc += M / 256; mt.tb[NEX] = acc; }
    __syncthreads();
}
template <bool GATHER>
struct MoeOrder {
    LAS const int* tb; LAS const int* cn; const int* tokl; int nN, G, c, total;
    __device__ __forceinline__ bool next(int i, pg8::Unit& u) const {
        const long L = (long)i * G + c; if (L >= total) return false;
        u.pm = (int)L / nN; u.pn = (int)L % nN;
        int lo = 0, hi = NEX;
        while (hi - lo > 1) { const int mid = (lo + hi) >> 1; if (tb[mid] <= u.pm) lo = mid; else hi = mid; }
        u.e = lo; return true;
    }
    __device__ __forceinline__ int tok(const pg8::Unit& u, int r) const {
        if (!GATHER) return u.pm * 256 + r;
        const int ri = (u.pm - tb[u.e]) * 256 + r;
        if (u.e == NE) return ri;
        return ri < cn[u.e] ? tokl[u.e * 8192 + ri] : 0;
    }
};

__device__ __forceinline__ void p17_combine(Frame& F, const MoeTab& mt, float* dst) {
    const int gw = F.vcu * NWAVES + F.wave, NGW = F.G * NWAVES, lane = F.lane;
    const int* idxo = WSP(int, WS_IDX); const int* sloto = idxo + M * 8; const float* gateo = (const float*)(sloto + M * 8);
    const bf16_t* outr = WSP(bf16_t, WS_OUTROWS); const float* g = INP(30); const float* bta = INP(31);
    for (int t = gw; t < M; t += NGW) {
        f32x4* xr = (f32x4*)(F.out + (size_t)t * DM);
        f32x4 v[8];
#pragma unroll
        for (int j = 0; j < 4; ++j) { v[2 * j] = xr[128 * j + 2 * lane] * DN_ALPHA; v[2 * j + 1] = xr[128 * j + 2 * lane + 1] * DN_ALPHA; }
        for (int k = 0; k < 9; ++k) {
            int row; float gt;
            if (k < 8) { const int e = idxo[t * 8 + k]; row = mt.tb[e] * 256 + sloto[t * 8 + k]; gt = gateo[t * 8 + k]; }
            else { row = mt.tb[NE] * 256 + t; gt = 1.0f; }
            const u32x4* rp = (const u32x4*)(outr + (size_t)row * DM);
#pragma unroll
            for (int j = 0; j < 4; ++j) { const u32x4 w = rp[64 * j + lane];
                v[2 * j] += (f32x4){bf_lo(w.x), bf_hi(w.x), bf_lo(w.y), bf_hi(w.y)} * gt; v[2 * j + 1] += (f32x4){bf_lo(w.z), bf_hi(w.z), bf_lo(w.w), bf_hi(w.w)} * gt; }
        }
        float s = 0.f;
#pragma unroll
        for (int j = 0; j < 8; ++j) s += (v[j].x + v[j].y) + (v[j].z + v[j].w);
        const float mean = wave_sum(s) * (1.f / DM); float s2 = 0.f;
#pragma unroll
        for (int j = 0; j < 8; ++j) { v[j] = v[j] - mean; s2 += (v[j].x * v[j].x + v[j].y * v[j].y) + (v[j].z * v[j].z + v[j].w * v[j].w); }
        const float rstd = 1.f / sqrtf(wave_sum(s2) * (1.f / DM) + LN_EPS);
#pragma unroll
        for (int j = 0; j < 4; ++j) {
#pragma unroll
            for (int q = 0; q < 2; ++q) { const int ci = 128 * j + 2 * lane + q; const f32x4 gg = *((const f32x4*)g + ci), bb = *((const f32x4*)bta + ci);
                ((f32x4*)(dst + (size_t)t * DM))[ci] = v[2 * j + q] * rstd * gg + bb; } }
    }
}
#ifndef MK_PER_PHASE
#define MK_PER_PHASE 0
#endif
constexpr int NPHASES = 18;
__global__ void __launch_bounds__(NWAVES * 64, 2) hybrid_fwd(Args args) {
    extern __shared__ __attribute__((aligned(16))) unsigned char lds[];
    Frame F;
    F.lds = (LAS unsigned char*)lds; F.ldsg = (char*)lds;
    F.wave = __builtin_amdgcn_readfirstlane((int)threadIdx.x >> 6); F.lane = fresh_lane(); F.tid = F.wave * 64 + F.lane;
    F.G = gridDim.x; { const int bx = blockIdx.x; F.vcu = (F.G % 8 == 0) ? (bx % 8) * (F.G / 8) + bx / 8 : bx; }
    F.ka = (const __attribute__((address_space(4))) char*)__builtin_amdgcn_kernarg_segment_ptr(); F.out = args.out; F.ws = args.ws; F.ctl = (unsigned*)(args.ws + WS_CTL);
    volatile LAS unsigned* MISC = (volatile LAS unsigned*)(F.lds + MISC_OFF);
    for (int u = F.tid; u < (LDS_BYTES - LDSCTL_OFF) / 4; u += NWAVES * 64) ((LAS unsigned*)(F.lds + LDSCTL_OFF))[u] = 0u;
    __syncthreads();
    XcdBarrier bar; bar.bar = F.ctl + CW_BAR; bar.x = 0; bar.st = nullptr; bar.wave = F.wave;
    const int lo = args.ph_lo, hi = args.ph_hi;
    if (hi - lo > 1) bar = xcd_barrier_post(F.ctl + CW_BAR, MISC + 8, F.wave);
#ifndef PHASE_MASK
#define PHASE_MASK 0xFFFFFFFFu
#endif
#define IN(k) (lo <= (k) && (k) < hi && ((PHASE_MASK >> (k)) & 1u))
#ifndef IDX_DUP_MODE
#define IDX_DUP_MODE 3
#endif
#ifndef DUP_MASK
#define DUP_MASK 0u
#endif
#define PHASE_BEGIN() do { asm volatile("" : "+s"(F.ka)); F.lane = fresh_lane(); F.tid = F.wave * 64 + F.lane; } while (0)
#ifndef PROBE_PHASE
#define PROBE_PHASE (-1)
#endif
#ifndef PROBE_MULT
#define PROBE_MULT 4
#endif
    unsigned long long pr_t0 = 0ull, pr_dt = 0ull;
#define SEAM(k) do { if (IN(k) && IN((k) + 1)) xcd_barrier(bar); \
        if (PROBE_PHASE >= 0) { if ((k) + 1 == PROBE_PHASE) pr_t0 = __builtin_amdgcn_s_memrealtime(); if ((k) == PROBE_PHASE) pr_dt = __builtin_amdgcn_s_memrealtime() - pr_t0; } } while (0)
    const MoeTab mt{(LAS int*)(F.lds + LDSCTL_OFF + 512), (LAS int*)(F.lds + LDSCTL_OFF + 512 + 272)};

    if (IN(0)) { PHASE_BEGIN(); { p0_prologue(F); }
        if ((DUP_MASK >> 0) & 1u) { xcd_barrier(bar); { p0_prologue(F); } } } SEAM(0);
    if (IN(1)) { PHASE_BEGIN(); { pg8::Gemm g{WSP(bf16_t, WS_XB), WSP(bf16_t, WS_WINT), 2048, 0}; pg8::DenseOrder S; S.init(M, LDP, F.G, (int)blockIdx.x);
        pg8::EpiProj E{WSP(bf16_t, WS_PROJ), LDP, WSP(float, WS_SIDE)};
        pg8::gemm_phase<pg8::EpiProj, pg8::DenseOrder, true>(F.lds + RING_OFF, g, S, E, F.wave); }
        __syncthreads();
        if (F.G == 256) { if ((int)blockIdx.x >= 96) expert_filler(F, 0, EXP_X1, (int)blockIdx.x - 96, 160); } else expert_filler(F, 0, EXP_X1, (int)blockIdx.x, F.G);
        if ((DUP_MASK >> 1) & 1u) { xcd_barrier(bar); { pg8::Gemm g{WSP(bf16_t, WS_XB), WSP(bf16_t, WS_WINT), 2048, 0}; pg8::DenseOrder S; S.init(M, LDP, F.G, (int)blockIdx.x);
        pg8::EpiProj E{WSP(bf16_t, WS_PROJ), LDP, WSP(float, WS_SIDE)};
        pg8::gemm_phase<pg8::EpiProj, pg8::DenseOrder, true>(F.lds + RING_OFF, g, S, E, F.wave); } } } SEAM(1);
    if (IN(2)) { PHASE_BEGIN(); { p2_token_norms(F); }
        if ((DUP_MASK >> 2) & 1u) { xcd_barrier(bar); { p2_token_norms(F); } } } SEAM(2);
    if (IN(3)) { PHASE_BEGIN(); { { pg8::Gemm g{WSP(bf16_t, WS_CB), WSP(bf16_t, WS_WKVS), 512, 0}; pg8::DenseOrder S; S.init(M, 2048, F.G, (int)blockIdx.x);
        pg8::EpiBf16 E{WSP(bf16_t, WS_KVS), 2048};
        pg8::gemm_phase<pg8::EpiBf16, pg8::DenseOrder, true>(F.lds + RING_OFF, g, S, E, F.wave); }
        p3_indexer<3>(F); }
        if ((DUP_MASK >> 3) & 1u) { xcd_barrier(bar); { p3_indexer<IDX_DUP_MODE>(F); } } } SEAM(3);
    if (IN(4)) { PHASE_BEGIN(); {
#if !defined(ATT_ONLY) || ATT_ONLY == 1
        attn_self_phase<false>(F, 0, 128); __syncthreads();
#endif
#if !defined(ATT_ONLY) || ATT_ONLY == 2
        attn_self_phase<true>(F, 128, 160);
#endif
        __syncthreads();
        if (F.G == 256) { if ((int)blockIdx.x >= 128) expert_filler(F, EXP_X1, EXP_X2, (int)blockIdx.x - 128, 128); } else expert_filler(F, EXP_X1, EXP_X2, (int)blockIdx.x, F.G);
    }
        if ((DUP_MASK >> 4) & 1u) { xcd_barrier(bar); {
#if !defined(ATT_ONLY) || ATT_ONLY == 1
        attn_self_phase<false>(F, 0, 128); __syncthreads();
#endif
#if !defined(ATT_ONLY) || ATT_ONLY == 2
        attn_self_phase<true>(F, 128, 160);
#endif
    } } } SEAM(4);
    if (IN(5)) { PHASE_BEGIN(); { p5_diff_combine(F); }
        if ((DUP_MASK >> 5) & 1u) { xcd_barrier(bar); { p5_diff_combine(F); } } } SEAM(5);
    if (IN(6)) { PHASE_BEGIN(); { pg8::Gemm g{WSP(bf16_t, WS_OD), WSP(bf16_t, WS_WPD), 2048, 0}; pg8::DenseOrder S; S.init(M, 2048, F.G, (int)blockIdx.x);
        pg8::EpiGateA E{WSP(bf16_t, WS_MERGED), 2048, WSP(bf16_t, WS_PROJ) + C_GD, LDP};
        pg8::gemm_phase<pg8::EpiGateA, pg8::DenseOrder, true>(F.lds + RING_OFF, g, S, E, F.wave); }
        if ((DUP_MASK >> 6) & 1u) { xcd_barrier(bar); { pg8::Gemm g{WSP(bf16_t, WS_OD), WSP(bf16_t, WS_WPD), 2048, 0}; pg8::DenseOrder S; S.init(M, 2048, F.G, (int)blockIdx.x);
        pg8::EpiGateA E{WSP(bf16_t, WS_MERGED), 2048, WSP(bf16_t, WS_PROJ) + C_GD, LDP};
        pg8::gemm_phase<pg8::EpiGateA, pg8::DenseOrder, true>(F.lds + RING_OFF, g, S, E, F.wave); } } } SEAM(6);
    if (IN(7)) { PHASE_BEGIN(); { pg8::Gemm g{WSP(bf16_t, WS_OS), WSP(bf16_t, WS_WPS), 1024, 0}; pg8::DenseOrder S; S.init(M, 2048, F.G, (int)blockIdx.x);
        pg8::EpiGateB E{WSP(bf16_t, WS_MERGED), 2048, WSP(bf16_t, WS_PROJ) + C_GS, LDP};
        pg8::gemm_phase<pg8::EpiGateB, pg8::DenseOrder, true>(F.lds + RING_OFF, g, S, E, F.wave); }
        if ((DUP_MASK >> 7) & 1u) { xcd_barrier(bar); { pg8::Gemm g{WSP(bf16_t, WS_OS), WSP(bf16_t, WS_WPS), 1024, 0}; pg8::DenseOrder S; S.init(M, 2048, F.G, (int)blockIdx.x);
        pg8::EpiGateB E{WSP(bf16_t, WS_MERGED), 2048, WSP(bf16_t, WS_PROJ) + C_GS, LDP};
        pg8::gemm_phase<pg8::EpiGateB, pg8::DenseOrder, true>(F.lds + RING_OFF, g, S, E, F.wave); } } } SEAM(7);
    if (IN(8)) { PHASE_BEGIN(); { pg8::Gemm g{WSP(bf16_t, WS_MERGED), WSP(bf16_t, WS_WMO), 2048, 0}; pg8::DenseOrder S; S.init(M, 2048, F.G, (int)blockIdx.x);
        pg8::EpiResid E{F.out, INP(0), 2048, DN_ALPHA};
        pg8::gemm_phase<pg8::EpiResid, pg8::DenseOrder, true>(F.lds + RING_OFF, g, S, E, F.wave); }
        if ((DUP_MASK >> 8) & 1u) { xcd_barrier(bar); { pg8::Gemm g{WSP(bf16_t, WS_MERGED), WSP(bf16_t, WS_WMO), 2048, 0}; pg8::DenseOrder S; S.init(M, 2048, F.G, (int)blockIdx.x);
        pg8::EpiResid E{F.out, INP(0), 2048, DN_ALPHA};
        pg8::gemm_phase<pg8::EpiResid, pg8::DenseOrder, true>(F.lds + RING_OFF, g, S, E, F.wave); } } } SEAM(8);
    if (IN(9)) { PHASE_BEGIN();
        if ((DUP_MASK >> 9) & 1u) { ln_phase(F, F.out, INP(15), INP(16), WSP(bf16_t, WS_OD), WSP(float, WS_ODRAW)); xcd_barrier(bar); }
        ln_phase(F, F.out, INP(15), INP(16), WSP(bf16_t, WS_HB), F.out); } SEAM(9);
    if (IN(10)) { PHASE_BEGIN(); { { pg8::Gemm g{WSP(bf16_t, WS_HB), WSP(bf16_t, WS_WXQ), 2048, 0}; pg8::DenseOrder S; S.init(M, 512, F.G, (int)blockIdx.x);
        pg8::EpiBf16 E{WSP(bf16_t, WS_XQ), 512};
        pg8::gemm_phase<pg8::EpiBf16, pg8::DenseOrder, true>(F.lds + RING_OFF, g, S, E, F.wave); }
        { pg8::Gemm g{WSP(bf16_t, WS_MEMB), WSP(bf16_t, WS_WXKV), 2048, 0}; pg8::DenseOrder S; S.init(1024, 1024, F.G, (int)blockIdx.x - 64);
        pg8::EpiBf16 E{WSP(bf16_t, WS_XKV), 1024};
        pg8::gemm_phase<pg8::EpiBf16, pg8::DenseOrder, true>(F.lds + RING_OFF, g, S, E, F.wave); }
        __syncthreads();
        if (F.G == 256) { if ((int)blockIdx.x >= 80) expert_filler(F, EXP_X2, EXP_X3, (int)blockIdx.x - 80, 176); } else expert_filler(F, EXP_X2, EXP_X3, (int)blockIdx.x, F.G); }
        if ((DUP_MASK >> 10) & 1u) { xcd_barrier(bar); { { pg8::Gemm g{WSP(bf16_t, WS_HB), WSP(bf16_t, WS_WXQ), 2048, 0}; pg8::DenseOrder S; S.init(M, 512, F.G, (int)blockIdx.x);
        pg8::EpiBf16 E{WSP(bf16_t, WS_XQ), 512};
        pg8::gemm_phase<pg8::EpiBf16, pg8::DenseOrder, true>(F.lds + RING_OFF, g, S, E, F.wave); }
        { pg8::Gemm g{WSP(bf16_t, WS_MEMB), WSP(bf16_t, WS_WXKV), 2048, 0}; pg8::DenseOrder S; S.init(1024, 1024, F.G, (int)blockIdx.x - 64);
        pg8::EpiBf16 E{WSP(bf16_t, WS_XKV), 1024};
        pg8::gemm_phase<pg8::EpiBf16, pg8::DenseOrder, true>(F.lds + RING_OFF, g, S, E, F.wave); } } } } SEAM(10);
    if (IN(11)) { PHASE_BEGIN(); { attn_cross_phase(F); }
        if ((DUP_MASK >> 11) & 1u) { xcd_barrier(bar); { attn_cross_phase(F); } } } SEAM(11);
    if (IN(12)) { PHASE_BEGIN(); { pg8::Gemm g{WSP(bf16_t, WS_XO), WSP(bf16_t, WS_WXO), 512, 0}; pg8::DenseOrder S; S.init(M, 2048, F.G, (int)blockIdx.x);
        pg8::EpiResid E{F.out, F.out, 2048, DN_ALPHA};
        pg8::gemm_phase<pg8::EpiResid, pg8::DenseOrder, true>(F.lds + RING_OFF, g, S, E, F.wave); }
        if ((DUP_MASK >> 12) & 1u) { xcd_barrier(bar); { pg8::Gemm g{WSP(bf16_t, WS_XO), WSP(bf16_t, WS_WXO), 512, 0}; pg8::DenseOrder S; S.init(M, 2048, F.G, (int)blockIdx.x);
        pg8::EpiResid E{F.out, F.out, 2048, DN_ALPHA};
        pg8::gemm_phase<pg8::EpiResid, pg8::DenseOrder, true>(F.lds + RING_OFF, g, S, E, F.wave); } } } SEAM(12);
    if (IN(13)) { PHASE_BEGIN();
        if ((DUP_MASK >> 13) & 1u) { ln_phase(F, F.out, INP(20), INP(21), WSP(bf16_t, WS_OD), WSP(float, WS_ODRAW)); xcd_barrier(bar); }
        ln_phase(F, F.out, INP(20), INP(21), WSP(bf16_t, WS_HB), F.out); } SEAM(13);
    if (IN(14)) { PHASE_BEGIN();
        if ((DUP_MASK >> 14) & 1u) { p13_router(F, F.ctl + CW_CNT + 8192, WSP(int, WS_OD), WSP(int, WS_OD + 4 * MiB)); xcd_barrier(bar); }
        p13_router(F, F.ctl + CW_CNT, WSP(int, WS_IDX), WSP(int, WS_TOKL)); } SEAM(14);
    if (IN(15)) { PHASE_BEGIN(); { moe_build_tab(F, mt);
        pg8::Gemm g{WSP(bf16_t, WS_HB), WSP(bf16_t, WS_W13T), 2048, (size_t)1024 * 2048 * 2};
        MoeOrder<true> S{mt.tb, mt.cn, WSP(int, WS_TOKL), 4, F.G, (int)blockIdx.x, mt.tb[NEX] * 4};
        pg8::EpiSilu E{WSP(bf16_t, WS_ACT), 512};
        pg8::gemm_phase<pg8::EpiSilu, MoeOrder<true>, true>(F.lds + RING_OFF, g, S, E, F.wave); }
        if ((DUP_MASK >> 15) & 1u) { xcd_barrier(bar); { moe_build_tab(F, mt);
        pg8::Gemm g{WSP(bf16_t, WS_HB), WSP(bf16_t, WS_W13T), 2048, (size_t)1024 * 2048 * 2};
        MoeOrder<true> S{mt.tb, mt.cn, WSP(int, WS_TOKL), 4, F.G, (int)blockIdx.x, mt.tb[NEX] * 4};
        pg8::EpiSilu E{WSP(bf16_t, WS_ACT), 512};
        pg8::gemm_phase<pg8::EpiSilu, MoeOrder<true>, true>(F.lds + RING_OFF, g, S, E, F.wave); } } } SEAM(15);
    if (IN(16)) { PHASE_BEGIN(); { moe_build_tab(F, mt);
        pg8::Gemm g{WSP(bf16_t, WS_ACT), WSP(bf16_t, WS_W2T), 512, (size_t)2048 * 512 * 2};
        MoeOrder<false> S{mt.tb, mt.cn, WSP(int, WS_TOKL), 8, F.G, (int)blockIdx.x, mt.tb[NEX] * 8};
        pg8::EpiBf16 E{WSP(bf16_t, WS_OUTROWS), 2048};
        pg8::gemm_phase<pg8::EpiBf16, MoeOrder<false>, true>(F.lds + RING_OFF, g, S, E, F.wave); }
        if ((DUP_MASK >> 16) & 1u) { xcd_barrier(bar); { moe_build_tab(F, mt);
        pg8::Gemm g{WSP(bf16_t, WS_ACT), WSP(bf16_t, WS_W2T), 512, (size_t)2048 * 512 * 2};
        MoeOrder<false> S{mt.tb, mt.cn, WSP(int, WS_TOKL), 8, F.G, (int)blockIdx.x, mt.tb[NEX] * 8};
        pg8::EpiBf16 E{WSP(bf16_t, WS_OUTROWS), 2048};
        pg8::gemm_phase<pg8::EpiBf16, MoeOrder<false>, true>(F.lds + RING_OFF, g, S, E, F.wave); } } } SEAM(16);
    if (IN(17)) { PHASE_BEGIN(); moe_build_tab(F, mt);
        if ((DUP_MASK >> 17) & 1u) { p17_combine(F, mt, WSP(float, WS_ODRAW)); xcd_barrier(bar); }
        p17_combine(F, mt, F.out); }
    if (PROBE_PHASE >= 0 && blockIdx.x == 0) {
        if (PROBE_PHASE == 17) pr_dt = __builtin_amdgcn_s_memrealtime() - pr_t0;
        const unsigned long long t_end = __builtin_amdgcn_s_memrealtime() + (unsigned long long)PROBE_MULT * pr_dt;
        while (__builtin_amdgcn_s_memrealtime() < t_end) __builtin_amdgcn_s_sleep(8);
    }
#undef IN
#undef SEAM
}

extern "C" void kernel_launch(void* const* d_in, const int* in_sizes, int n_in, void* d_out, int out_size, void* d_ws, size_t ws_size, hipStream_t stream) {
    static int grid = 0;
    if (grid == 0) {
        if (n_in != 32 || out_size != M * DM || ws_size < WS_END) { fprintf(stderr, "kernel_launch: unexpected shapes (n_in %d, out %d, ws %zu); nothing launched\n", n_in, out_size, ws_size); grid = -1; return; }
        int dev = 0, cus = 0, per_cu = 0;
        if (hipGetDevice(&dev) != hipSuccess || hipDeviceGetAttribute(&cus, hipDeviceAttributeMultiprocessorCount, dev) != hipSuccess) { grid = -1; return; }
        if (hipFuncSetAttribute((const void*)hybrid_fwd, hipFuncAttributeMaxDynamicSharedMemorySize, LDS_BYTES) != hipSuccess) { fprintf(stderr, "kernel_launch: hipFuncSetAttribute failed\n"); grid = -1; return; }
        if (hipOccupancyMaxActiveBlocksPerMultiprocessor(&per_cu, (const void*)hybrid_fwd, NWAVES * 64, LDS_BYTES) != hipSuccess || per_cu < 1) { fprintf(stderr, "kernel_launch: occupancy query says %d\n", per_cu); }
        (void)hipGetLastError();
        grid = cus;
    }
    if (grid < 0) return;
    (void)hipMemsetAsync((char*)d_ws + WS_CTL, 0, CTL_ZERO_BYTES, stream);
    Args a{};
    for (int i = 0; i < 32; ++i) a.in[i] = (const float*)d_in[i];
    a.out = (float*)d_out; a.ws = (unsigned char*)d_ws;
#if MK_PER_PHASE
    for (int p = 0; p < NPHASES; ++p) { a.ph_lo = p; a.ph_hi = p + 1; hipLaunchKernelGGL(hybrid_fwd, dim3(grid), dim3(NWAVES * 64), LDS_BYTES, stream, a); }
#else
    a.ph_lo = 0; a.ph_hi = NPHASES;
    hipLaunchKernelGGL(hybrid_fwd, dim3(grid), dim3(NWAVES * 64), LDS_BYTES, stream, a);
#endif
}
```
